# Optimizing an MI355X kernel written in HIP

```python
import math
import jax, jax.numpy as jnp
from jax import lax
import numpy as np

D_MODEL = 1024
BATCH = 1
SEQ = 16384
DEPTH = 1
DEC_BATCH = 8
DEC_SEQ = 64
PAST_LEN = 1024

CHUNK = 64
Q_BLOCK = 128
A_HEADS = 4
A_QK_DIM = 64
A_V_DIM = 2 * A_QK_DIM
B_HEADS = 8
B_DIM = 64
A_WIDTH = A_HEADS * A_V_DIM
B_WIDTH = B_HEADS * B_DIM
MIX_WIDTH = A_WIDTH + B_WIDTH
ROT_DIM = A_QK_DIM // 4
ROPE_THETA = 500000.0
EPS = 1e-6
A_QK_WIDTH = A_HEADS * 2 * A_QK_DIM
IN_WIDTH = 2 * A_QK_WIDTH + 2 * A_WIDTH + 4 * B_WIDTH + B_HEADS
FORGET_BIAS = 3.0

kernel_name = "hybrid_diff_fox_stream_step"

F32 = jnp.float32


def rms_norm(x, g):
    xf = x.astype(F32)
    y = xf * lax.rsqrt(jnp.mean(xf * xf, axis=-1, keepdims=True) + EPS)
    return y.astype(x.dtype) * g


def rope(x, pos):
    t = x.shape[1]
    half = ROT_DIM // 2
    inv = ROPE_THETA ** (-jnp.arange(0, ROT_DIM, 2, dtype=F32) / ROT_DIM)
    ang = pos.astype(F32)[:, None] * inv[None, :]
    shape = (1, t) + (1,) * (x.ndim - 3) + (half,)
    cos = jnp.cos(ang).reshape(shape).astype(x.dtype)
    sin = jnp.sin(ang).reshape(shape).astype(x.dtype)
    x1 = x[..., :half]
    x2 = x[..., half:ROT_DIM]
    return jnp.concatenate([x1 * cos - x2 * sin, x2 * cos + x1 * sin, x[..., ROT_DIM:]], axis=-1)


def split_offsets():
    sizes = [A_QK_WIDTH, A_QK_WIDTH, A_WIDTH, A_WIDTH, B_WIDTH, B_WIDTH, B_WIDTH, B_HEADS, B_WIDTH]
    offs = []
    s = 0
    for n in sizes[:-1]:
        s += n
        offs.append(s)
    return offs


def project(x, c, pos, norm_g, w_ada, b_ada, w_in, b_f, qn_a, kn_a, qn_b, kn_b):
    b, t = x.shape[:2]
    mod = jax.nn.silu(c) @ w_ada + b_ada
    shift, scale, gate = jnp.split(mod, 3, axis=-1)
    h = rms_norm(x, norm_g) * (1.0 + scale[:, None, :]) + shift[:, None, :]
    u = h @ w_in
    qa, ka, va, za, qb, kb, vb, fb, zb = jnp.split(u, split_offsets(), axis=-1)
    qa = rope(rms_norm(qa.reshape(b, t, A_HEADS, 2, A_QK_DIM), qn_a), pos)
    ka = rope(rms_norm(ka.reshape(b, t, A_HEADS, 2, A_QK_DIM), kn_a), pos)
    va = va.reshape(b, t, A_HEADS, A_V_DIM)
    qb = rms_norm(qb.reshape(b, t, B_HEADS, B_DIM), qn_b)
    kb = rms_norm(kb.reshape(b, t, B_HEADS, B_DIM), kn_b)
    vb = vb.reshape(b, t, B_HEADS, B_DIM)
    logf = jax.nn.log_sigmoid((fb + b_f).astype(F32))
    return gate, qa, ka, va, za, qb, kb, vb, zb, logf


def diff_attention(q, k, v, mask, lam):
    s = jnp.einsum('bqhjd,bkhjd->bhjqk', q, k).astype(F32) * (A_QK_DIM ** -0.5)
    p = jax.nn.softmax(jnp.where(mask, s, -jnp.inf), axis=-1)
    a = p[:, :, 0] - lam * p[:, :, 1]
    return jnp.einsum('bhqk,bkhe->bqhe', a.astype(v.dtype), v)


def forgetting_attention(q, k, v, mask, bias):
    s = jnp.einsum('bqhd,bkhd->bhqk', q, k).astype(F32) * (B_DIM ** -0.5) + bias
    p = jax.nn.softmax(jnp.where(mask, s, -jnp.inf), axis=-1)
    return jnp.einsum('bhqk,bkhd->bqhd', p.astype(v.dtype), v)


def merge(x, gate, oa, za, ob, zb, subln_g, lam_init, w_out):
    b, t = x.shape[:2]
    oa = rms_norm(oa, subln_g) * (1.0 - lam_init)
    ga = oa.reshape(b, t, A_WIDTH) * jax.nn.silu(za)
    gb = ob.reshape(b, t, B_WIDTH) * jax.nn.silu(zb)
    o = jnp.concatenate([ga, gb], axis=-1) @ w_out
    return x + gate[:, None, :] * o


def setup_inputs(seed: int = 0) -> dict:
    key = jax.random.key(seed)
    ks = jax.random.split(key, 32)
    nrm = jax.random.normal
    d = D_MODEL
    inp = {}
    inp['x_prompt'] = nrm(ks[0], (BATCH, SEQ, d), F32)
    inp['x_sample'] = nrm(ks[1], (DEC_BATCH, DEC_SEQ, d), F32)
    inp['cache_a_k'] = nrm(ks[2], (DEPTH, DEC_BATCH, PAST_LEN, A_HEADS, 2, A_QK_DIM), F32)
    inp['cache_a_v'] = nrm(ks[3], (DEPTH, DEC_BATCH, PAST_LEN, A_HEADS, A_V_DIM), F32)
    inp['cache_b_k'] = nrm(ks[4], (DEPTH, DEC_BATCH, PAST_LEN, B_HEADS, B_DIM), F32)
    inp['cache_b_v'] = nrm(ks[5], (DEPTH, DEC_BATCH, PAST_LEN, B_HEADS, B_DIM), F32)
    inp['cache_b_logf'] = jax.nn.log_sigmoid(FORGET_BIAS + nrm(ks[6], (DEPTH, DEC_BATCH, PAST_LEN, B_HEADS), F32))
    inp['c_prompt'] = nrm(ks[7], (BATCH, d), F32)
    inp['c_sample'] = nrm(ks[8], (DEC_BATCH, d), F32)
    inp['norm_g'] = 1.0 + 0.02 * nrm(ks[9], (DEPTH, d), F32)
    inp['w_ada'] = nrm(ks[10], (DEPTH, d, 3 * d), F32) * d ** -0.5
    inp['b_ada'] = 0.01 * nrm(ks[11], (DEPTH, 3 * d), F32)
    inp['w_in'] = nrm(ks[12], (DEPTH, d, IN_WIDTH), F32) * d ** -0.5
    inp['b_f'] = FORGET_BIAS + 0.1 * nrm(ks[13], (DEPTH, B_HEADS), F32)
    inp['qn_a'] = 1.0 + 0.02 * nrm(ks[14], (DEPTH, A_QK_DIM), F32)
    inp['kn_a'] = 1.0 + 0.02 * nrm(ks[15], (DEPTH, A_QK_DIM), F32)
    inp['lam_q1'] = 0.1 * nrm(ks[16], (DEPTH, A_QK_DIM), F32)
    inp['lam_k1'] = 0.1 * nrm(ks[17], (DEPTH, A_QK_DIM), F32)
    inp['lam_q2'] = 0.1 * nrm(ks[18], (DEPTH, A_QK_DIM), F32)
    inp['lam_k2'] = 0.1 * nrm(ks[19], (DEPTH, A_QK_DIM), F32)
    inp['subln_g'] = 1.0 + 0.02 * nrm(ks[20], (DEPTH, A_V_DIM), F32)
    inp['qn_b'] = 1.0 + 0.02 * nrm(ks[21], (DEPTH, B_DIM), F32)
    inp['kn_b'] = 1.0 + 0.02 * nrm(ks[22], (DEPTH, B_DIM), F32)
    inp['w_out'] = nrm(ks[23], (DEPTH, MIX_WIDTH, d), F32) * MIX_WIDTH ** -0.5
    return inp


def reference(x_prompt, x_sample, cache_a_k, cache_a_v, cache_b_k, cache_b_v, cache_b_logf,
              c_prompt, c_sample, norm_g, w_ada, b_ada, w_in, b_f, qn_a, kn_a,
              lam_q1, lam_k1, lam_q2, lam_k2, subln_g, qn_b, kn_b, w_out):
    xp = x_prompt
    xs = x_sample
    bp, seq = xp.shape[:2]
    bs, tdec = xs.shape[:2]
    past = cache_a_k.shape[2]
    n_blocks = seq // Q_BLOCK
    pos_p = jnp.arange(seq)
    pos_s = past + jnp.arange(tdec)
    kpos_s = jnp.arange(past + tdec)
    mask_a_s = (kpos_s // CHUNK)[None, :] <= (pos_s // CHUNK)[:, None]
    mask_b_s = kpos_s[None, :] <= pos_s[:, None]
    pa_k, pa_v, pb_k, pb_v, pb_f = [], [], [], [], []
    sa_k, sa_v, sb_k, sb_v, sb_f = [], [], [], [], []
    for l in range(DEPTH):
        lam_init = 0.8 - 0.6 * math.exp(-0.3 * l)
        lam = (jnp.exp(jnp.sum((lam_q1[l] * lam_k1[l]).astype(F32)))
               - jnp.exp(jnp.sum((lam_q2[l] * lam_k2[l]).astype(F32))) + lam_init)
        lw = (norm_g[l], w_ada[l], b_ada[l], w_in[l], b_f[l], qn_a[l], kn_a[l], qn_b[l], kn_b[l])

        gate, qa, ka, va, za, qb, kb, vb, zb, logf = project(xp, c_prompt, pos_p, *lw)
        cum_t = jnp.cumsum(logf, axis=1).transpose(0, 2, 1)

        def prompt_block(i):
            start = i * Q_BLOCK
            qpos = start + jnp.arange(Q_BLOCK)
            mask_a = (pos_p // CHUNK)[None, :] <= (qpos // CHUNK)[:, None]
            oa_blk = diff_attention(lax.dynamic_slice_in_dim(qa, start, Q_BLOCK, axis=1), ka, va, mask_a, lam)
            cq = lax.dynamic_slice_in_dim(cum_t, start, Q_BLOCK, axis=2)
            bias = cq[:, :, :, None] - cum_t[:, :, None, :]
            mask_b = pos_p[None, :] <= qpos[:, None]
            ob_blk = forgetting_attention(lax.dynamic_slice_in_dim(qb, start, Q_BLOCK, axis=1), kb, vb, mask_b, bias)
            return oa_blk, ob_blk

        oa_b, ob_b = lax.map(prompt_block, jnp.arange(n_blocks))
        oa = jnp.moveaxis(oa_b, 0, 1).reshape(bp, seq, A_HEADS, A_V_DIM)
        ob = jnp.moveaxis(ob_b, 0, 1).reshape(bp, seq, B_HEADS, B_DIM)
        xp = merge(xp, gate, oa, za, ob, zb, subln_g[l], lam_init, w_out[l])
        pa_k.append(ka); pa_v.append(va); pb_k.append(kb); pb_v.append(vb); pb_f.append(logf)

        gate_s, qa_s, ka_s, va_s, za_s, qb_s, kb_s, vb_s, zb_s, logf_s = project(xs, c_sample, pos_s, *lw)
        ka_all = jnp.concatenate([cache_a_k[l].astype(ka_s.dtype), ka_s], axis=1)
        va_all = jnp.concatenate([cache_a_v[l].astype(va_s.dtype), va_s], axis=1)
        oa_s = diff_attention(qa_s, ka_all, va_all, mask_a_s, lam)
        kb_all = jnp.concatenate([cache_b_k[l].astype(kb_s.dtype), kb_s], axis=1)
        vb_all = jnp.concatenate([cache_b_v[l].astype(vb_s.dtype), vb_s], axis=1)
        cum_s = jnp.cumsum(jnp.concatenate([cache_b_logf[l].astype(F32), logf_s], axis=1), axis=1).transpose(0, 2, 1)
        bias_s = cum_s[:, :, past:, None] - cum_s[:, :, None, :]
        ob_s = forgetting_attention(qb_s, kb_all, vb_all, mask_b_s, bias_s)
        xs = merge(xs, gate_s, oa_s, za_s, ob_s, zb_s, subln_g[l], lam_init, w_out[l])
        sa_k.append(ka_s); sa_v.append(va_s); sb_k.append(kb_s); sb_v.append(vb_s); sb_f.append(logf_s)

    return (xp, xs,
            jnp.stack(pa_k), jnp.stack(pa_v), jnp.stack(pb_k), jnp.stack(pb_v), jnp.stack(pb_f),
            jnp.stack(sa_k), jnp.stack(sa_v), jnp.stack(sb_k), jnp.stack(sb_v), jnp.stack(sb_f))
```

```cpp
#include <hip/hip_runtime.h>
#include <hip/hip_cooperative_groups.h>
#include <cstdio>
#include <cstdint>
namespace cg = cooperative_groups;

#ifndef PROBE
#define PROBE 0
#endif
#ifndef MK_LAUNCHES
#define MK_LAUNCHES 1
#endif

typedef short bf16x8 __attribute__((ext_vector_type(8)));
typedef short s16x4 __attribute__((ext_vector_type(4)));
typedef float f32x16 __attribute__((ext_vector_type(16)));
typedef float f32x4 __attribute__((ext_vector_type(4)));
typedef float f32x2 __attribute__((ext_vector_type(2)));
typedef __bf16 bf16x2_t __attribute__((ext_vector_type(2)));
typedef unsigned u32x4 __attribute__((ext_vector_type(4)));
typedef unsigned u32x2 __attribute__((ext_vector_type(2)));
#define LDSP __attribute__((address_space(3)))
#define DI __device__ __forceinline__
#define MFMA(a, b, c) __builtin_amdgcn_mfma_f32_32x32x16_bf16((a), (b), (c), 0, 0, 0)

constexpr int TP = 16384, TS = 512, T = TP + TS, DM = 1024, NU = 4096, WIN_LD = 4104;
constexpr int NTHR = 512;
constexpr float LOG2E = 1.4426950408889634f;
constexpr long O_Y = 0, O_YS = 16777216, O_AKP = 17301504, O_AVP = 25690112, O_BKP = 34078720, O_BVP = 42467328, O_LFP = 50855936,
               O_AKS = 50987008, O_AVS = 51249152, O_BKS = 51511296, O_BVS = 51773440, O_LFS = 52035584;
constexpr size_t al256(size_t x) { return (x + 255) / 256 * 256; }
constexpr size_t WS_CTRL = 0;
constexpr size_t WS_MOD = 32768;
constexpr size_t WS_MISC = al256(WS_MOD + 9 * 3072 * 4);
constexpr size_t WS_WFB = WS_MISC + 256;
constexpr size_t WS_ITEMS = WS_WFB + 8 * 1024 * 4;
constexpr size_t WS_CUMP = WS_ITEMS + 2048 * 4;
constexpr size_t WS_CUMS = WS_CUMP + 8 * 16384 * 4;
constexpr size_t WS_LOGF = al256(WS_CUMS + 64 * 1088 * 4);
constexpr size_t WS_WTIN = al256(WS_LOGF + (size_t)T * 8 * 4);
constexpr size_t WS_WTOUT = WS_WTIN + (size_t)4096 * 1024 * 2;
constexpr size_t WS_CAK = WS_WTOUT + (size_t)1024 * 1024 * 2;
constexpr size_t WS_CAV = WS_CAK + (size_t)8 * 1024 * 512 * 2;
constexpr size_t WS_CBK = WS_CAV + (size_t)8 * 1024 * 512 * 2;
constexpr size_t WS_CBV = WS_CBK + (size_t)8 * 1024 * 512 * 2;
constexpr size_t WS_H = WS_CBV + (size_t)8 * 1024 * 512 * 2;
constexpr size_t WS_U = WS_H + (size_t)T * 1024 * 2;
constexpr size_t WS_END = WS_U + (size_t)T * 4096 * 2;
constexpr int N_ITEMS = 1120;
constexpr int LDS_BYTES = 112640;

struct Params {
  const float *x_prompt, *x_sample, *cache_a_k, *cache_a_v, *cache_b_k, *cache_b_v, *cache_b_logf, *c_prompt, *c_sample,
      *norm_g, *w_ada, *b_ada, *w_in, *b_f, *qn_a, *kn_a, *lam_q1, *lam_k1, *lam_q2, *lam_k2, *subln_g, *qn_b, *kn_b, *w_out;
  float* out; char* ws;
};

DI unsigned pk2(float a, float b) { f32x2 v = {a, b}; bf16x2_t r = __builtin_convertvector(v, bf16x2_t); return __builtin_bit_cast(unsigned, r); }
DI bf16x8 pk8(float a, float b, float c, float d, float e, float f, float g, float h) { u32x4 w = {pk2(a, b), pk2(c, d), pk2(e, f), pk2(g, h)}; return __builtin_bit_cast(bf16x8, w); }
DI float bf2f(unsigned short v) { return __uint_as_float(((unsigned)v) << 16); }
DI float wave_sum(float v) {
#pragma unroll
  for (int o = 32; o > 0; o >>= 1) v += __shfl_xor(v, o);
  return v;
}
DI float wave_max(float v) {
#pragma unroll
  for (int o = 32; o > 0; o >>= 1) v = fmaxf(v, __shfl_xor(v, o));
  return v;
}
DI int crow0(int r) { return (r & 3) + 8 * (r >> 2); }
DI float silu_f(float z) { return z / (1.f + __expf(-z)); }
DI s16x4 tr_read(unsigned lds_addr) { return __builtin_amdgcn_ds_read_tr16_b64_v4i16((LDSP s16x4*)lds_addr); }

constexpr int J_MOD = 96, J_MISC = 1, J_WIN = 1024, J_WOUT = 256, J_CVT = 256;
constexpr int J_TOTAL = J_MOD + J_MISC + J_WIN + J_WOUT + J_CVT;

DI void prep_mod_job(const Params& p, char* lds, int job, int tid) {
  float* sc = (float*)lds;
  float* red = (float*)(lds + 9 * 1024 * 4);
  for (int i = tid; i < 9 * 1024; i += NTHR) { const int b = i >> 10, k = i & 1023; const float c = b == 0 ? p.c_prompt[k] : p.c_sample[(b - 1) * 1024 + k]; sc[i] = c / (1.f + expf(-c)); }
  __syncthreads();
  const int c = tid & 31, kq = tid >> 5, n = job * 32 + c;
  float acc[9];
#pragma unroll
  for (int b = 0; b < 9; ++b) acc[b] = 0.f;
  const float* wp = p.w_ada + (size_t)(kq * 64) * 3072 + n;
#pragma unroll 8
  for (int k = 0; k < 64; ++k) {
    const float w = wp[(size_t)k * 3072];
#pragma unroll
    for (int b = 0; b < 9; ++b) acc[b] += sc[b * 1024 + kq * 64 + k] * w;
  }
#pragma unroll
  for (int b = 0; b < 9; ++b) red[(kq * 9 + b) * 32 + c] = acc[b];
  __syncthreads();
  for (int i = tid; i < 9 * 32; i += NTHR) {
    const int b = i >> 5, cc = i & 31; float s = 0.f;
#pragma unroll
    for (int q = 0; q < 16; ++q) s += red[(q * 9 + b) * 32 + cc];
    ((float*)(p.ws + WS_MOD))[b * 3072 + job * 32 + cc] = s + p.b_ada[job * 32 + cc];
  }
  __syncthreads();
}

DI int item_cost(int e) { if (e < 512) return 3 * (2 * (e >> 2) + 2); if (e < 1024) return 2 * (4 * ((e - 512) >> 3) + 4); if (e < 1056) return 51; return 34; }
DI int item_code(int e) {
  if (e < 512) return (0 << 16) | ((e & 3) << 8) | (e >> 2);
  if (e < 1024) { e -= 512; return (1 << 16) | ((e & 7) << 8) | (e >> 3); }
  if (e < 1056) { e -= 1024; return (2 << 16) | ((e & 3) << 8) | (e >> 2); }
  e -= 1056; return (3 << 16) | ((e & 7) << 8) | (e >> 3);
}

DI void prep_misc_job(const Params& p, char* lds, int tid) {
  float* misc = (float*)(p.ws + WS_MISC);
  const int w = tid >> 6, l = tid & 63;
  if (w == 0) {
    const float s1 = wave_sum(p.lam_q1[l] * p.lam_k1[l]), s2 = wave_sum(p.lam_q2[l] * p.lam_k2[l]);
    if (l == 0) misc[0] = expf(s1) - expf(s2) + 0.2f;
  } else if (w == 1) {
    const float a = wave_max(fabsf(p.qn_a[l])), b = wave_max(fabsf(p.kn_a[l]));
    if (l == 0) misc[1] = 8.f * a * b * LOG2E * 1.02f;
  } else if (w == 2) {
    const float a = wave_max(fabsf(p.qn_b[l])), b = wave_max(fabsf(p.kn_b[l]));
    if (l == 0) misc[2] = 8.f * a * b * LOG2E * 1.02f;
  }
  float* wfb = (float*)(p.ws + WS_WFB);
  for (int i = tid; i < 8192; i += NTHR) { const int k = i >> 3, j = i & 7; wfb[j * 1024 + k] = p.w_in[(size_t)k * WIN_LD + 3584 + j]; }
  __syncthreads();
}

DI void prep_tr_job(const float* src, int ld, short* dst, char* lds, int tid) {
  float* tile = (float*)lds;
#pragma unroll
  for (int i = 0; i < 8; ++i) { const int e = tid + NTHR * i, r = e >> 6, c = e & 63; tile[r * 65 + c] = src[(size_t)r * ld + c]; }
  __syncthreads();
  const int n = tid >> 3, kc = tid & 7;
  float v[8];
#pragma unroll
  for (int i = 0; i < 8; ++i) v[i] = tile[(kc * 8 + i) * 65 + n];
  *(bf16x8*)(dst + (size_t)n * 1024 + kc * 8) = pk8(v[0], v[1], v[2], v[3], v[4], v[5], v[6], v[7]);
  __syncthreads();
}

constexpr int J_HEAD = J_MOD + J_MISC + J_WIN;
DI void phase_prep(const Params& p, char* lds, int job_begin, int job_end, int start, int stride, int tid) {
  for (int job = job_begin + start; job < job_end; job += stride) {
    int j = job;
    if (j < J_MOD) { prep_mod_job(p, lds, j, tid); continue; }
    j -= J_MOD;
    if (j < J_MISC) { prep_misc_job(p, lds, tid); continue; }
    j -= J_MISC;
    if (j < J_WIN) { const int kt = j >> 6, nt = j & 63; const int n0 = nt * 64, sn0 = n0 < 3584 ? n0 : n0 + 8;
      prep_tr_job(p.w_in + (size_t)(kt * 64) * WIN_LD + sn0, WIN_LD, (short*)(p.ws + WS_WTIN) + (size_t)n0 * 1024 + kt * 64, lds, tid); continue; }
    j -= J_WIN;
    if (j < J_WOUT) { const int kt = j >> 4, nt = j & 15;
      prep_tr_job(p.w_out + (size_t)(kt * 64) * 1024 + nt * 64, 1024, (short*)(p.ws + WS_WTOUT) + (size_t)(nt * 64) * 1024 + kt * 64, lds, tid); continue; }
    j -= J_WOUT;
    { const int which = j >> 6, part = j & 63;
      const float* src = which == 0 ? p.cache_a_k : which == 1 ? p.cache_a_v : which == 2 ? p.cache_b_k : p.cache_b_v;
      short* dst = (short*)(p.ws + (which == 0 ? WS_CAK : which == 1 ? WS_CAV : which == 2 ? WS_CBK : WS_CBV));
      const size_t base = (size_t)part * 65536;
#pragma unroll 4
      for (int i = 0; i < 16; ++i) { const size_t o = base + (size_t)(i * NTHR + tid) * 8; const f32x4 a = *(const f32x4*)(src + o), b = *(const f32x4*)(src + o + 4);
        *(bf16x8*)(dst + o) = pk8(a[0], a[1], a[2], a[3], b[0], b[1], b[2], b[3]); } }
  }
}

DI void phase_hpass(const Params& p, char* lds, int bid, int nb, int tid) {
  float* wfb_s = (float*)lds;
  for (int i = tid; i < 2048; i += NTHR) ((f32x4*)wfb_s)[i] = ((const f32x4*)(p.ws + WS_WFB))[i];
  __syncthreads();
  const int w = tid >> 6, l = tid & 63;
  const float* modp = (const float*)(p.ws + WS_MOD);
  short* H = (short*)(p.ws + WS_H);
  float* logf_ws = (float*)(p.ws + WS_LOGF);
  int cur_b = -1; f32x4 ga[4], sb[4];
#pragma unroll
  for (int i = 0; i < 4; ++i) { ga[i] = (f32x4){0.f, 0.f, 0.f, 0.f}; sb[i] = ga[i]; }
  for (int tok = bid * 8 + w; tok < T; tok += nb * 8) {
    const bool pr = tok < TP;
    const float* xr = pr ? p.x_prompt + (size_t)tok * 1024 : p.x_sample + (size_t)(tok - TP) * 1024;
    const int bidx = pr ? 0 : 1 + ((tok - TP) >> 6);
    if (bidx != cur_b) { cur_b = bidx; const float* md = modp + bidx * 3072;
#pragma unroll
      for (int i = 0; i < 4; ++i) { const int c = i * 256 + l * 4; const f32x4 g = *(const f32x4*)(p.norm_g + c), scl = *(const f32x4*)(md + 1024 + c); ga[i] = g * (1.f + scl); sb[i] = *(const f32x4*)(md + c); } }
    f32x4 xv[4]; float ss = 0.f;
#pragma unroll
    for (int i = 0; i < 4; ++i) { xv[i] = *(const f32x4*)(xr + i * 256 + l * 4); ss += xv[i][0] * xv[i][0] + xv[i][1] * xv[i][1] + xv[i][2] * xv[i][2] + xv[i][3] * xv[i][3]; }
    ss = wave_sum(ss);
    const float rstd = rsqrtf(ss * (1.f / 1024.f) + 1e-6f);
    float fb[8];
#pragma unroll
    for (int j = 0; j < 8; ++j) fb[j] = 0.f;
#pragma unroll
    for (int i = 0; i < 4; ++i) {
      const int c = i * 256 + l * 4;
      f32x4 hv;
#pragma unroll
      for (int e = 0; e < 4; ++e) hv[e] = (xv[i][e] * rstd) * ga[i][e] + sb[i][e];
      u32x2 hw = {pk2(hv[0], hv[1]), pk2(hv[2], hv[3])};
      *(u32x2*)(H + (size_t)tok * 1024 + c) = hw;
#pragma unroll
      for (int j = 0; j < 8; ++j) { const f32x4 wv = *(const f32x4*)(wfb_s + j * 1024 + c); fb[j] += hv[0] * wv[0] + hv[1] * wv[1] + hv[2] * wv[2] + hv[3] * wv[3]; }
    }
#pragma unroll
    for (int i = 0; i < 4; ++i) { const float send = (l & 1) ? fb[i] : fb[i + 4], keep = (l & 1) ? fb[i + 4] : fb[i]; fb[i] = keep + __shfl_xor(send, 1); }
#pragma unroll
    for (int i = 0; i < 2; ++i) { const float send = (l & 2) ? fb[i] : fb[i + 2], keep = (l & 2) ? fb[i + 2] : fb[i]; fb[i] = keep + __shfl_xor(send, 2); }
    { const float send = (l & 4) ? fb[0] : fb[1], keep = (l & 4) ? fb[1] : fb[0]; fb[0] = keep + __shfl_xor(send, 4); }
    float v = fb[0];
    v += __shfl_xor(v, 8); v += __shfl_xor(v, 16); v += __shfl_xor(v, 32);
    const int jl = ((l >> 2) & 1) + 2 * ((l >> 1) & 1) + 4 * (l & 1);
    if (l < 8) {
      const float z = v + p.b_f[jl];
      const float lf = fminf(z, 0.f) - log1pf(expf(-fabsf(z)));
      logf_ws[(size_t)tok * 8 + jl] = lf;
      if (pr) p.out[O_LFP + (size_t)tok * 8 + jl] = lf; else p.out[O_LFS + (size_t)(tok - TP) * 8 + jl] = lf;
    }
  }
  __syncthreads();
}

DI float block_excl_scan(float v, float* sm, int tid) {
  const int w = tid >> 6, l = tid & 63;
  float inc = v;
#pragma unroll
  for (int o = 1; o < 64; o <<= 1) { const float t = __shfl_up(inc, o); if (l >= o) inc += t; }
  if (l == 63) sm[w] = inc;
  __syncthreads();
  float pre = 0.f;
#pragma unroll
  for (int i = 0; i < 8; ++i) pre += (i < w) ? sm[i] : 0.f;
  __syncthreads();
  return pre + inc - v;
}
DI void scan_job(const Params& p, char* lds, int job, int tid) {
  float* sm = (float*)lds;
  const float* logf_ws = (const float*)(p.ws + WS_LOGF);
  if (job < 8) {
    const int hh = job; float* cum = (float*)(p.ws + WS_CUMP) + hh * 16384;
    float vals[32]; float s = 0.f;
#pragma unroll
    for (int i = 0; i < 32; ++i) { vals[i] = logf_ws[(size_t)(tid * 32 + i) * 8 + hh]; s += vals[i]; }
    float run = block_excl_scan(s, sm, tid);
#pragma unroll
    for (int i = 0; i < 32; ++i) { run += vals[i]; cum[tid * 32 + i] = run; }
  } else {
    const int bh = job - 8, b = bh >> 3, hh = bh & 7; float* cum = (float*)(p.ws + WS_CUMS) + bh * 1088;
    float vals[3]; float s = 0.f;
#pragma unroll
    for (int i = 0; i < 3; ++i) { const int k = tid * 3 + i; float v = 0.f;
      if (k < 1024) v = p.cache_b_logf[(size_t)(b * 1024 + k) * 8 + hh]; else if (k < 1088) v = logf_ws[(size_t)(TP + b * 64 + (k - 1024)) * 8 + hh];
      vals[i] = v; s += v; }
    float run = block_excl_scan(s, sm, tid);
#pragma unroll
    for (int i = 0; i < 3; ++i) { const int k = tid * 3 + i; run += vals[i]; if (k < 1088) cum[k] = run; }
  }
}

template <int NBW>
DI void gemm_main(const short* __restrict__ Ag, const short* __restrict__ Bg, char* lds, f32x16 (&acc)[2][NBW], int tid) {
  constexpr int STAGE = 16384 + 16384 * NBW;
  const int w = __builtin_amdgcn_readfirstlane(tid >> 6), l = tid & 63, r32 = l & 31, h = l >> 5, wa = w & 1, wb = w >> 1;
  const int gch = (l & 7) ^ (((l >> 4) + 4 * w) & 7);
  const short* agl = Ag + (size_t)(8 * w + (l >> 3)) * 1024 + gch * 8;
  const short* bgl = Bg + (size_t)(8 * w + (l >> 3)) * 1024 + gch * 8;
  const unsigned lds0 = (unsigned)(uintptr_t)lds + (unsigned)w * 1024u;
#pragma unroll
  for (int ab = 0; ab < 2; ++ab)
#pragma unroll
    for (int bb = 0; bb < NBW; ++bb)
#pragma unroll
      for (int r = 0; r < 16; ++r) acc[ab][bb][r] = 0.f;
#define G_DMA(kt, st) do { const unsigned b_ = lds0 + (unsigned)((st) * STAGE); \
    _Pragma("unroll") for (int i = 0; i < 2; ++i) __builtin_amdgcn_global_load_lds((const unsigned*)(agl + (size_t)i * 64 * 1024 + (kt) * 64), (LDSP unsigned*)(b_ + i * 8192), 16, 0, 0); \
    _Pragma("unroll") for (int i = 0; i < 2 * NBW; ++i) __builtin_amdgcn_global_load_lds((const unsigned*)(bgl + (size_t)i * 64 * 1024 + (kt) * 64), (LDSP unsigned*)(b_ + 16384 + i * 8192), 16, 0, 0); } while (0)
  G_DMA(0, 0);
  asm volatile("s_waitcnt vmcnt(0)" ::: "memory");
  __syncthreads();
  const int fswz = (r32 >> 1) & 7;
  const int aoff = (wa * 64 + r32) * 128, boff = 16384 + (wb * 32 * NBW + r32) * 128;
  for (int kt = 0; kt < 16; ++kt) {
    if (kt < 15) G_DMA(kt + 1, (kt + 1) & 1);
    const char* base = lds + (kt & 1) * STAGE;
#pragma unroll
    for (int ks = 0; ks < 4; ++ks) {
      const int co = ((2 * ks + h) ^ fswz) << 4;
      bf16x8 af[2], bf[NBW];
#pragma unroll
      for (int ab = 0; ab < 2; ++ab) af[ab] = *(const bf16x8*)(base + aoff + ab * 4096 + co);
#pragma unroll
      for (int bb = 0; bb < NBW; ++bb) bf[bb] = *(const bf16x8*)(base + boff + bb * 4096 + co);
      __builtin_amdgcn_s_setprio(1);
#pragma unroll
      for (int ab = 0; ab < 2; ++ab)
#pragma unroll
        for (int bb = 0; bb < NBW; ++bb) acc[ab][bb] = MFMA(af[ab], bf[bb], acc[ab][bb]);
      __builtin_amdgcn_s_setprio(0);
    }
    asm volatile("s_waitcnt vmcnt(0)" ::: "memory");
    __syncthreads();
  }
#undef G_DMA
}

DI void store4(float* of, short* ub, float a, float b, float c, float d) {
  if (of) { f32x4 v = {a, b, c, d}; *(f32x4*)of = v; }
  u32x2 w = {pk2(a, b), pk2(c, d)}; *(u32x2*)ub = w;
}
DI void phase_gemm1(const Params& p, char* lds, int bid, int nb, int tid) {
  const int w = __builtin_amdgcn_readfirstlane(tid >> 6), l = tid & 63, r32 = l & 31, h = l >> 5, wa = w & 1, wb = w >> 1;
  const short* Wt = (const short*)(p.ws + WS_WTIN);
  const short* H = (const short*)(p.ws + WS_H);
  short* U = (short*)(p.ws + WS_U);
  char* scr = lds + w * 12288;
  constexpr int SP = 272;
  const bool xmap = (nb & 7) == 0;
  const int xq = bid & 7, jl = bid >> 3, nbx = nb >> 3;
  for (int it = 0;; ++it) {
    int mt, nt;
    if (xmap) { const int t = it * nbx + jl; if (t >= 33 * 8) break; mt = 2 * (t >> 3) + (xq >> 2); nt = 8 * (xq & 3) + (t & 7); }
    else { const int tile = it * nb + bid; if (tile >= 66 * 32) break; mt = tile >> 5; nt = tile & 31; }
    f32x16 acc[2][2];
    gemm_main<2>(Wt + (size_t)nt * 128 * 1024, H + (size_t)mt * 256 * 1024, lds, acc, tid);
    const int n0 = nt * 128 + wa * 64, g = n0 >> 6, seg = g >> 3, gi = g & 7;
    const bool norm = (seg == 0 || seg == 1 || seg == 4 || seg == 5), rope = seg < 2, silu = (seg == 3 || seg == 7);
    const float* gain = seg == 0 ? p.qn_a : seg == 1 ? p.kn_a : seg == 4 ? p.qn_b : p.kn_b;
    const float qscale = (seg == 0 || seg == 4) ? 0.125f * LOG2E : 1.f;
    long obase = -1;
    const bool prm = mt < 64;
    if (seg == 1) obase = prm ? O_AKP : O_AKS; else if (seg == 2) obase = prm ? O_AVP : O_AVS; else if (seg == 5) obase = prm ? O_BKP : O_BKS; else if (seg == 6) obase = prm ? O_BVP : O_BVS;
    const int ocol = gi * 64;
#pragma unroll
    for (int bb = 0; bb < 2; ++bb) {
      const int tok0 = mt * 256 + wb * 64 + bb * 32;
      const int tok = tok0 + r32;
      float rstd = 1.f;
      if (norm) {
        float ss = 0.f;
#pragma unroll
        for (int ab = 0; ab < 2; ++ab)
#pragma unroll
          for (int r = 0; r < 16; ++r) ss += acc[ab][bb][r] * acc[ab][bb][r];
        ss += __shfl_xor(ss, 32);
        rstd = rsqrtf(ss * (1.f / 64.f) + 1e-6f);
      }
      float cs[4], sn[4];
      if (rope) {
        const int pos = prm ? tok : 1024 + ((tok - TP) & 63);
#pragma unroll
        for (int r = 0; r < 4; ++r) {
          const int i = 4 * h + r;
          const double inv = i == 0 ? 0.15915494309189535 : i == 1 ? 0.03086376340470123 : i == 2 ? 0.005985185712713705 : i == 3 ? 0.001160663641240061 : i == 4 ? 0.00022507907903927653 : i == 5 ? 4.364795279280289e-05 : i == 6 ? 8.464330808241401e-06 : 1.6414262627950345e-06;
          double rev = (double)pos * inv;
          rev -= rint(rev);
          const float revf = (float)rev;
          cs[r] = __builtin_amdgcn_cosf(revf); sn[r] = __builtin_amdgcn_sinf(revf);
        }
      }
#pragma unroll
      for (int ab = 0; ab < 2; ++ab) {
        float v[16];
#pragma unroll
        for (int r = 0; r < 16; ++r) v[r] = acc[ab][bb][r];
        if (norm) {
#pragma unroll
          for (int rq = 0; rq < 4; ++rq) { const f32x4 gv = *(const f32x4*)(gain + ab * 32 + 8 * rq + 4 * h);
#pragma unroll
            for (int e = 0; e < 4; ++e) v[4 * rq + e] = v[4 * rq + e] * rstd * gv[e]; }
        }
        if (rope && ab == 0) {
#pragma unroll
          for (int r = 0; r < 4; ++r) { const float x1 = v[r], x2 = v[r + 4]; v[r] = x1 * cs[r] - x2 * sn[r]; v[r + 4] = x2 * cs[r] + x1 * sn[r]; }
        }
#pragma unroll
        for (int rq = 0; rq < 4; ++rq) {
          float a0 = v[4 * rq], a1 = v[4 * rq + 1], a2 = v[4 * rq + 2], a3 = v[4 * rq + 3];
          if (silu) { a0 = silu_f(a0); a1 = silu_f(a1); a2 = silu_f(a2); a3 = silu_f(a3); }
          const f32x4 vv = {a0, a1, a2, a3};
          *(f32x4*)(scr + r32 * SP + (ab * 32 + 8 * rq + 4 * h) * 4) = vv;
        }
      }
      const int orow0 = prm ? tok0 : tok0 - TP;
      if (obase >= 0) {
#pragma unroll
        for (int i = 0; i < 8; ++i) {
          const int row = 4 * i + (l >> 4);
          const f32x4 vv = *(const f32x4*)(scr + row * SP + (l & 15) * 16);
          *(f32x4*)(p.out + obase + (size_t)(orow0 + row) * 512 + ocol + (l & 15) * 4) = vv;
        }
      }
#pragma unroll
      for (int i = 0; i < 4; ++i) {
        const int row = 8 * i + (l >> 3);
        const f32x4 va = *(const f32x4*)(scr + row * SP + (l & 7) * 32), vb = *(const f32x4*)(scr + row * SP + (l & 7) * 32 + 16);
        *(bf16x8*)(U + (size_t)(tok0 + row) * 4096 + n0 + (l & 7) * 8) = pk8(va[0] * qscale, va[1] * qscale, va[2] * qscale, va[3] * qscale, vb[0] * qscale, vb[1] * qscale, vb[2] * qscale, vb[3] * qscale);
      }
    }
    __syncthreads();
  }
}


template <bool ISB> struct AC {
  static constexpr int KP = ISB ? 128 : 256, VP = ISB ? 192 : 320, NDB = ISB ? 2 : 4;
  static constexpr int KT = 64 * KP, VT = 64 * VP, CKB = ISB ? 256 : 0, SLOT = KT + VT + CKB;
};

template <bool ISB, bool FAST>
DI void attn_step(char* lds, unsigned lds0, int kslot, int hk, int vslot, int hv, int hu, bool doQK, bool doExp, bool doPV, bool mask,
                  const bf16x8 (&qf)[4], const f32x16& initC, float cqp, int qm, int koff_lane, int cbase, int kswz, unsigned vbase, int h,
                  const f32x16& Sc, f32x16& Sn, bf16x8 (&pf)[2], f32x16 (&O)[AC<ISB>::NDB], float& lsum) {
  typedef AC<ISB> C;
  bf16x8 kf[4];
#pragma unroll
  for (int r = 0; r < 16; ++r) Sn[r] = 0.f;
  if (FAST || doQK) {
    const char* kb = lds + kslot + hk * 32 * C::KP + koff_lane;
#pragma unroll
    for (int ks = 0; ks < 4; ++ks) kf[ks] = *(const bf16x8*)(kb + (((cbase + 2 * ks) ^ kswz) << 4));
    if (ISB) {
      const float* ck = (const float*)(lds + kslot + C::KT + C::VT) + hk * 32 + 4 * h;
#pragma unroll
      for (int rq = 0; rq < 4; ++rq) { const f32x4 c0 = *(const f32x4*)(ck + 8 * rq);
#pragma unroll
        for (int e = 0; e < 4; ++e) Sn[4 * rq + e] = cqp - c0[e]; }
    }
  }
  const unsigned va = lds0 + vslot + C::KT + vbase + hv * 32 * C::VP;
  bf16x8 vf0[C::NDB];
  if (FAST || doPV) {
#pragma unroll
    for (int db = 0; db < C::NDB; ++db) {
      const s16x4 t0 = tr_read(va + 64 * db), t1 = tr_read(va + 8 * C::VP + 64 * db);
      vf0[db] = __builtin_shufflevector(t0, t1, 0, 1, 2, 3, 4, 5, 6, 7);
    }
  }
  if (FAST) __builtin_amdgcn_s_setprio(1);
  if (FAST || doQK) {
#pragma unroll
    for (int ks = 0; ks < 4; ++ks) Sn = MFMA(kf[ks], qf[ks], Sn);
  }
  if (FAST || doPV) {
    bf16x8 vf1[C::NDB];
#pragma unroll
    for (int db = 0; db < C::NDB; ++db) {
      const s16x4 t0 = tr_read(va + 16 * C::VP + 64 * db), t1 = tr_read(va + 24 * C::VP + 64 * db);
      vf1[db] = __builtin_shufflevector(t0, t1, 0, 1, 2, 3, 4, 5, 6, 7);
    }
#pragma unroll
    for (int db = 0; db < C::NDB; ++db) O[db] = MFMA(vf0[db], pf[0], O[db]);
#pragma unroll
    for (int db = 0; db < C::NDB; ++db) O[db] = MFMA(vf1[db], pf[1], O[db]);
  }
  if (FAST || doExp) {
    f32x16 pv = Sc;
    if (!FAST && ISB && mask) {
      const int qmh = qm - 32 * hu;
#pragma unroll
      for (int r = 0; r < 16; ++r) if (crow0(r) > qmh) pv[r] = -INFINITY;
    }
#pragma unroll
    for (int r = 0; r < 16; ++r) pv[r] = __builtin_amdgcn_exp2f(pv[r]);
    float s0 = (pv[0] + pv[1]) + (pv[2] + pv[3]), s1 = (pv[4] + pv[5]) + (pv[6] + pv[7]), s2 = (pv[8] + pv[9]) + (pv[10] + pv[11]), s3 = (pv[12] + pv[13]) + (pv[14] + pv[15]);
    lsum += (s0 + s1) + (s2 + s3);
    pf[0] = pk8(pv[0], pv[1], pv[2], pv[3], pv[4], pv[5], pv[6], pv[7]);
    pf[1] = pk8(pv[8], pv[9], pv[10], pv[11], pv[12], pv[13], pv[14], pv[15]);
  }
  if (FAST) __builtin_amdgcn_s_setprio(0);
}

template <bool ISB>
DI void attn_item(const Params& p, char* lds, bool sample, int hh, int idx, int tid_in) {
  typedef AC<ISB> C;
  int tid = tid_in; asm volatile("" : "+v"(tid));
  const int w = tid >> 6, l = tid & 63, r32 = l & 31, h = l >> 5;
  const int qs = ISB ? w : (w >> 1), j = ISB ? 0 : (w & 1);
  const short* U = (const short*)(p.ws + WS_U);
  const float* misc = (const float*)(p.ws + WS_MISC);
  const float lam = misc[0], CS = ISB ? misc[2] : misc[1];
  constexpr int QCOL = ISB ? 2048 : 0, KCOL = ISB ? 2560 : 512, ZCOL = ISB ? 3584 : 1536, HW = ISB ? 64 : 128, NH = ISB ? 8 : 4;
  int nt, chunk; size_t qtok; const float* cum = nullptr; float cq = 0.f;
  if (!sample) {
    if (ISB) { nt = 4 * idx + 4; chunk = 4 * idx + (w >> 1); qtok = (size_t)idx * 256 + w * 32 + r32; cum = (const float*)(p.ws + WS_CUMP) + hh * 16384; cq = cum[qtok]; }
    else { nt = 2 * idx + 2; chunk = 2 * idx + (qs >> 1); qtok = (size_t)idx * 128 + qs * 32 + r32; }
  } else {
    nt = 17; chunk = qs < 2 ? 16 : -1; qtok = (size_t)TP + idx * 64 + (qs & 1) * 32 + r32;
    if (ISB) { cum = (const float*)(p.ws + WS_CUMS) + (idx * 8 + hh) * 1088; cq = cum[1024 + (qs & 1) * 32 + r32]; }
  }
  int kt0 = 0;
  if (ISB) {
    const int qfirst = sample ? 1024 : idx * 256;
    const float cqf = cum[qfirst] * LOG2E;
    const int pred = (tid < nt - 4) && (cqf - cum[64 * tid + 63] * LOG2E < -170.f);
    kt0 = __syncthreads_count(pred);
    nt -= kt0; if (chunk >= 0) chunk -= kt0;
  }
  const int umax = 2 * chunk + 1;
  const float cqp = cq * LOG2E - CS;
  const int qm = (qs & 1) * 32 + r32 - 4 * h;
  bf16x8 qf[4];
#pragma unroll
  for (int ks = 0; ks < 4; ++ks) qf[ks] = *(const bf16x8*)(U + qtok * 4096 + QCOL + hh * HW + j * 64 + ks * 16 + h * 8);
  f32x16 O[C::NDB];
#pragma unroll
  for (int db = 0; db < C::NDB; ++db)
#pragma unroll
    for (int r = 0; r < 16; ++r) O[db][r] = 0.f;
  f32x16 initC;
#pragma unroll
  for (int r = 0; r < 16; ++r) initC[r] = -CS;
  float lsum = 0.f;
  constexpr int NCH = ISB ? 1 : 2;
  const int srow = ISB ? (tid >> 3) : (tid >> 4), sch = ISB ? (tid & 7) : (tid & 15);
  const int k_st = ISB ? srow * 128 + ((sch ^ ((srow >> 1) & 7)) << 4) : srow * 256 + ((sch ^ (srow & 15)) << 4);
  const int v_st = C::KT + srow * C::VP + sch * 16;
  u32x4 rk[NCH], rv[NCH]; f32x4 rc = {0.f, 0.f, 0.f, 0.f};
  const short* cache_k = (const short*)(p.ws + (ISB ? WS_CBK : WS_CAK));
  const short* cache_v = (const short*)(p.ws + (ISB ? WS_CBV : WS_CAV));
#define KV_PTR(ktr, kp_, vp_, pitch_) const short *kp_, *vp_; size_t pitch_; const int kt_ = (ktr) + kt0; \
    if (!sample) { kp_ = U + (size_t)(kt_ * 64) * 4096 + KCOL + hh * HW; vp_ = kp_ + 512; pitch_ = 4096; } \
    else if (kt_ < 16) { const size_t o_ = ((size_t)(idx * 1024 + kt_ * 64) * NH + hh) * HW; kp_ = cache_k + o_; vp_ = cache_v + o_; pitch_ = 512; } \
    else { kp_ = U + (size_t)(TP + idx * 64) * 4096 + KCOL + hh * HW; vp_ = kp_ + 512; pitch_ = 4096; }
#define LOAD_K(kt) do { KV_PTR(kt, kp_, vp_, pitch_); (void)vp_; _Pragma("unroll") for (int i = 0; i < NCH; ++i) rk[i] = *(const u32x4*)(kp_ + (size_t)(srow + 32 * i) * pitch_ + sch * 8); \
    if (ISB && tid < 16) rc = *(const f32x4*)(cum + ((kt) + kt0) * 64 + tid * 4); } while (0)
#define LOAD_V(kt) do { KV_PTR(kt, kp_, vp_, pitch_); (void)kp_; _Pragma("unroll") for (int i = 0; i < NCH; ++i) rv[i] = *(const u32x4*)(vp_ + (size_t)(srow + 32 * i) * pitch_ + sch * 8); } while (0)
#define STORE_K(slot) do { char* b_ = lds + (slot); _Pragma("unroll") for (int i = 0; i < NCH; ++i) *(u32x4*)(b_ + k_st + i * 32 * C::KP) = rk[i]; \
    if (ISB && tid < 16) { const f32x4 t_ = rc * LOG2E; *(f32x4*)(b_ + C::KT + C::VT + tid * 16) = t_; } } while (0)
#define STORE_V(slot) do { char* b_ = lds + (slot); _Pragma("unroll") for (int i = 0; i < NCH; ++i) *(u32x4*)(b_ + v_st + i * 32 * C::VP) = rv[i]; } while (0)
  const unsigned lds0 = (unsigned)(uintptr_t)lds;
  const unsigned vbase = (4 * h + ((l & 15) >> 2)) * C::VP + (16 * ((l >> 4) & 1) + 4 * (l & 3)) * 2;
  const int kswz = ISB ? ((r32 >> 1) & 7) : (r32 & 15);
  const int koff_lane = r32 * C::KP, cbase = j * 8 + h;
  LOAD_K(0); LOAD_V(0); STORE_K(0); STORE_V(0);
  LOAD_K(1); STORE_K(C::SLOT);
  __syncthreads();
  f32x16 Sa = initC, Sb = initC; bf16x8 pf[2] = {};
  if (umax >= 0) attn_step<ISB, false>(lds, lds0, 0, 0, 0, 0, 0, true, false, false, false, qf, initC, cqp, qm, koff_lane, cbase, kswz, vbase, h, Sb, Sa, pf, O, lsum);
  int s0 = 0, s1 = C::SLOT, s2 = 2 * C::SLOT;
  for (int kt = 0; kt < nt; ++kt) {
    if (kt + 2 < nt) LOAD_K(kt + 2);
    if (kt + 1 < nt) LOAD_V(kt + 1);
#define HSTEP(hf, SIN, SOUT) do { const int u = 2 * kt + (hf); \
      const bool doQK = u + 1 <= umax, doExp = u <= umax, doPV = u >= 1 && u - 1 <= umax; \
      const bool mask = ISB && u >= 2 * chunk; \
      const int kslot = (hf) == 0 ? s0 : s1, hk = (hf) == 0 ? 1 : 0, vslot = (hf) == 0 ? s2 : s0, hv = (hf) == 0 ? 1 : 0; \
      if (doQK && doPV && !mask) attn_step<ISB, true>(lds, lds0, kslot, hk, vslot, hv, (hf), true, true, true, false, qf, initC, cqp, qm, koff_lane, cbase, kswz, vbase, h, SIN, SOUT, pf, O, lsum); \
      else if (doExp || doPV) attn_step<ISB, false>(lds, lds0, kslot, hk, vslot, hv, (hf), doQK, doExp, doPV, mask, qf, initC, cqp, qm, koff_lane, cbase, kswz, vbase, h, SIN, SOUT, pf, O, lsum); } while (0)
    HSTEP(0, Sa, Sb);
    HSTEP(1, Sb, Sa);
#undef HSTEP
    if (kt + 2 < nt) STORE_K(s2);
    if (kt + 1 < nt) STORE_V(s1);
    __syncthreads();
    const int t_ = s0; s0 = s1; s1 = s2; s2 = t_;
  }
  if (umax == 2 * nt - 1) attn_step<ISB, false>(lds, lds0, 0, 0, s2, 1, 0, false, false, true, false, qf, initC, cqp, qm, koff_lane, cbase, kswz, vbase, h, Sa, Sb, pf, O, lsum);
#undef KV_PTR
#undef LOAD_K
#undef LOAD_V
#undef STORE_K
#undef STORE_V
  __syncthreads();
  lsum += __shfl_xor(lsum, 32);
  const float rl = 1.f / lsum;
  short* G = (short*)(p.ws + WS_H);
  if (ISB) {
    if (umax >= 0) {
#pragma unroll
      for (int db = 0; db < C::NDB; ++db)
#pragma unroll
        for (int rq = 0; rq < 4; ++rq) {
          const int d = db * 32 + 8 * rq + 4 * h;
          const u32x2 zw = *(const u32x2*)(U + qtok * 4096 + ZCOL + hh * 64 + d);
          const float z0 = __uint_as_float(zw[0] << 16), z1 = __uint_as_float(zw[0] & 0xffff0000u), z2 = __uint_as_float(zw[1] << 16), z3 = __uint_as_float(zw[1] & 0xffff0000u);
          u32x2 ow = {pk2(O[db][4 * rq] * rl * z0, O[db][4 * rq + 1] * rl * z1), pk2(O[db][4 * rq + 2] * rl * z2, O[db][4 * rq + 3] * rl * z3)};
          *(u32x2*)(G + qtok * 1024 + 512 + hh * 64 + d) = ow;
        }
    }
  } else {
    float* X = (float*)lds + (size_t)qs * 4096;
    if (j == 1 && umax >= 0) {
#pragma unroll
      for (int db = 0; db < C::NDB; ++db)
#pragma unroll
        for (int r = 0; r < 16; ++r) X[(db * 16 + r) * 64 + l] = O[db][r] * rl;
    }
    __syncthreads();
    if (j == 0 && umax >= 0) {
      float ss = 0.f;
#pragma unroll
      for (int db = 0; db < C::NDB; ++db)
#pragma unroll
        for (int r = 0; r < 16; ++r) { const float d = O[db][r] * rl - lam * X[(db * 16 + r) * 64 + l]; O[db][r] = d; ss += d * d; }
      ss += __shfl_xor(ss, 32);
      const float rstd = rsqrtf(ss * (1.f / 128.f) + 1e-6f) * 0.8f;
#pragma unroll
      for (int db = 0; db < C::NDB; ++db)
#pragma unroll
        for (int rq = 0; rq < 4; ++rq) {
          const int d = db * 32 + 8 * rq + 4 * h;
          const f32x4 gv = *(const f32x4*)(p.subln_g + d);
          const u32x2 zw = *(const u32x2*)(U + qtok * 4096 + ZCOL + hh * 128 + d);
          const float z0 = __uint_as_float(zw[0] << 16), z1 = __uint_as_float(zw[0] & 0xffff0000u), z2 = __uint_as_float(zw[1] << 16), z3 = __uint_as_float(zw[1] & 0xffff0000u);
          u32x2 ow = {pk2(O[db][4 * rq] * rstd * gv[0] * z0, O[db][4 * rq + 1] * rstd * gv[1] * z1), pk2(O[db][4 * rq + 2] * rstd * gv[2] * z2, O[db][4 * rq + 3] * rstd * gv[3] * z3)};
          *(u32x2*)(G + qtok * 1024 + hh * 128 + d) = ow;
        }
    }
    __syncthreads();
  }
}


constexpr int Q_LEN = 140;
DI void phase_attn(const Params& p, char* lds, int tid, int which = 0) {
  unsigned* qh = (unsigned*)(p.ws + WS_CTRL) + which * 8 * 16;
  int* s_item = (int*)(lds + LDS_BYTES - 16);
  const int xcc = (int)(__builtin_amdgcn_s_getreg((3 << 11) | 20) & 7u);
  for (;;) {
    if (tid == 0) {
      int found = -1;
      for (int a = 0; a < 8 && found < 0; ++a) {
        const int y = (xcc + a) & 7;
        if (__hip_atomic_load(qh + y * 16, __ATOMIC_RELAXED, __HIP_MEMORY_SCOPE_AGENT) >= (unsigned)Q_LEN) continue;
        const unsigned v = atomicAdd(qh + y * 16, 1u);
        if (v < (unsigned)Q_LEN) found = y * 256 + (int)v;
      }
      *s_item = found;
    }
    __syncthreads();
    const int it = *s_item;
    __syncthreads();
    if (it < 0) break;
    const int x = it >> 8, i = it & 255;
    if (i < 64) attn_item<false>(p, lds, false, x & 3, 2 * (63 - i) + (x >> 2), tid);
    else if (i < 128) attn_item<true>(p, lds, false, x, 127 - i, tid);
    else if (i < 132) { const int e = x * 4 + (i - 128); attn_item<false>(p, lds, true, e & 3, e >> 2, tid); }
    else { const int e = x * 8 + (i - 132); attn_item<true>(p, lds, true, e & 7, e >> 3, tid); }
  }
}

template <int NBW>
DI void gemm2_tile(const Params& p, char* lds, int mt, int ncol0, int tid) {
  const int w = __builtin_amdgcn_readfirstlane(tid >> 6), l = tid & 63, r32 = l & 31, h = l >> 5, wa = w & 1, wb = w >> 1;
  const short* G = (const short*)(p.ws + WS_H);
  const short* Wt = (const short*)(p.ws + WS_WTOUT);
  const float* modp = (const float*)(p.ws + WS_MOD);
  f32x16 acc[2][NBW];
  gemm_main<NBW>(G + (size_t)mt * 128 * 1024, Wt + (size_t)ncol0 * 1024, lds, acc, tid);
  const int tok0 = mt * 128 + wa * 64;
  const bool prm = tok0 < TP;
  const float* gatep = modp + (prm ? 0 : 1 + ((tok0 - TP) >> 6)) * 3072 + 2048;
  const float* xb = prm ? p.x_prompt + (size_t)tok0 * 1024 : p.x_sample + (size_t)(tok0 - TP) * 1024;
  float* yb = prm ? p.out + O_Y + (size_t)tok0 * 1024 : p.out + O_YS + (size_t)(tok0 - TP) * 1024;
  char* scr = lds + w * 12288;
  constexpr int SP = 272, LPR = 8 * NBW, RPI = 64 / LPR, NIT = 32 / RPI;
  const int ncw = ncol0 + wb * 32 * NBW;
  const f32x4 gate4 = *(const f32x4*)(gatep + ncw + (l % LPR) * 4);
#pragma unroll
  for (int ab = 0; ab < 2; ++ab) {
#pragma unroll
    for (int bb = 0; bb < NBW; ++bb)
#pragma unroll
      for (int r = 0; r < 16; ++r) *(float*)(scr + (crow0(r) + 4 * h) * SP + (bb * 32 + r32) * 4) = acc[ab][bb][r];
#pragma unroll
    for (int i = 0; i < NIT; ++i) {
      const int row = RPI * i + l / LPR;
      const f32x4 o = *(const f32x4*)(scr + row * SP + (l % LPR) * 16);
      const size_t off = (size_t)(ab * 32 + row) * 1024 + ncw + (l % LPR) * 4;
      const f32x4 xv = *(const f32x4*)(xb + off);
      *(f32x4*)(yb + off) = xv + gate4 * o;
    }
  }
  __syncthreads();
}
DI void phase_gemm2(const Params& p, char* lds, int bid, int nb, int tid) {
  constexpr int NT = 132 * 4;
  const int full = (NT / nb) * nb;
  for (int tile = bid; tile < full; tile += nb) gemm2_tile<2>(p, lds, tile >> 2, (tile & 3) * 256, tid);
  for (int ht = bid; ht < (NT - full) * 2; ht += nb) { const int tile = full + (ht >> 1); gemm2_tile<1>(p, lds, tile >> 2, (tile & 3) * 256 + (ht & 1) * 128, tid); }
}

constexpr size_t XB_SUB = 8192, XB_GEN = 8192 + 4096, XB_TOP = 8192 + 8192, XB_TOPGEN = XB_TOP + 256, XB_XCC = 20480;
DI unsigned xb_ld(unsigned* p) { return __hip_atomic_load(p, __ATOMIC_RELAXED, __HIP_MEMORY_SCOPE_AGENT); }
DI unsigned xb_add(unsigned* p, unsigned v) { return __hip_atomic_fetch_add(p, v, __ATOMIC_RELAXED, __HIP_MEMORY_SCOPE_AGENT); }
DI void xcd_barrier(char* ctrl, const unsigned* st, unsigned k) {
  asm volatile("s_waitcnt vmcnt(0)" ::: "memory");
  __syncthreads();
  if (threadIdx.x == 0) {
    const unsigned x = st[0], nloc = st[1], nx = st[2];
    unsigned* xsub = (unsigned*)(ctrl + XB_SUB + 256 * x); unsigned* xgen = (unsigned*)(ctrl + XB_GEN + 256 * x);
    unsigned* top = (unsigned*)(ctrl + XB_TOP); unsigned* topgen = (unsigned*)(ctrl + XB_TOPGEN);
    unsigned spins = 0;
    const unsigned old = xb_add(xsub, 1u);
    if (old + 1u == k * nloc) {
      __builtin_amdgcn_fence(__ATOMIC_RELEASE, "agent");
      asm volatile("s_waitcnt vmcnt(0)" ::: "memory");
      const unsigned og = xb_add(top, 1u);
      if (og + 1u == k * nx) xb_add(topgen, 1u);
      else while (xb_ld(topgen) < k) { __builtin_amdgcn_s_sleep(1); if (++spins > (1u << 24)) break; }
      __builtin_amdgcn_fence(__ATOMIC_ACQUIRE, "agent");
      xb_add(xgen, 1u);
      asm volatile("s_waitcnt vmcnt(0)" ::: "memory");
    } else {
      while (xb_ld(xgen) < k) { __builtin_amdgcn_s_sleep(1); if (++spins > (1u << 24)) break; }
      __builtin_amdgcn_fence(__ATOMIC_ACQUIRE, "agent");
      asm volatile("s_waitcnt vmcnt(0)" ::: "memory");
    }
  }
  __syncthreads();
}

extern __shared__ __attribute__((aligned(16))) char smem[];

__global__ void __launch_bounds__(NTHR, 1) mega_kernel(Params p) {
  cg::grid_group grid = cg::this_grid(); (void)grid;
  const int tid = threadIdx.x, bid = blockIdx.x, nb = gridDim.x;
  unsigned* xst = (unsigned*)(smem + LDS_BYTES - 32);
  const unsigned my_xcc = __builtin_amdgcn_s_getreg((3 << 11) | 20) & 7u;
  unsigned* census = (unsigned*)(p.ws + WS_CTRL + XB_XCC);
  if (tid == 0) xb_add(census + 64 * my_xcc, 1u);
  { constexpr int JS = J_MOD + J_MISC;
    if (nb > 2 * JS) { if (bid < JS) phase_prep(p, smem, 0, JS, bid, nb, tid); else phase_prep(p, smem, JS, J_HEAD, bid - JS, nb - JS, tid); }
    else phase_prep(p, smem, 0, J_HEAD, bid, nb, tid); }
  if (tid == 0) {
    unsigned tot = 0, nx = 0, mine = 0, spins = 0;
    for (;;) { tot = 0; nx = 0;
      for (int x = 0; x < 8; ++x) { const unsigned c = xb_ld(census + 64 * x); tot += c; nx += c ? 1u : 0u; if ((unsigned)x == my_xcc) mine = c; }
      if (tot >= (unsigned)nb || ++spins > (1u << 22)) break;
      __builtin_amdgcn_s_sleep(2); }
    xst[0] = my_xcc; xst[1] = mine; xst[2] = nx;
  }
  __syncthreads();
  xcd_barrier(p.ws + WS_CTRL, xst, 1u);
  phase_hpass(p, smem, bid, nb, tid);
#if PROBE == 5
  phase_hpass(p, smem, bid, nb, tid);
#endif
  xcd_barrier(p.ws + WS_CTRL, xst, 2u);
  phase_gemm1(p, smem, bid, nb, tid);
  { const int extra = (66 * 32) % nb;
    if (bid >= extra) {
      for (int job = bid - extra; job < 72; job += nb - extra) { scan_job(p, smem, job, tid); __syncthreads(); }
      phase_prep(p, smem, J_HEAD, J_TOTAL, bid - extra, nb - extra, tid); } }
  xcd_barrier(p.ws + WS_CTRL, xst, 3u);
  phase_attn(p, smem, tid);
#if PROBE == 1
  phase_attn(p, smem, tid, 1);
#endif
  xcd_barrier(p.ws + WS_CTRL, xst, 4u);
  phase_gemm2(p, smem, bid, nb, tid);
#if PROBE == 3
  phase_gemm2(p, smem, bid, nb, tid);
#endif
}

#if MK_LAUNCHES != 1
__global__ void __launch_bounds__(NTHR, 1) k_prep(Params p) { phase_prep(p, smem, 0, J_TOTAL, blockIdx.x, gridDim.x, threadIdx.x); }
__global__ void __launch_bounds__(NTHR, 1) k_hpass(Params p) { phase_hpass(p, smem, blockIdx.x, gridDim.x, threadIdx.x); }
__global__ void __launch_bounds__(NTHR, 1) k_gemm1(Params p) {
  for (int job = blockIdx.x; job < 72; job += gridDim.x) { scan_job(p, smem, job, threadIdx.x); __syncthreads(); }
  phase_gemm1(p, smem, blockIdx.x, gridDim.x, threadIdx.x);
}
__global__ void __launch_bounds__(NTHR, 1) k_attn(Params p) { phase_attn(p, smem, threadIdx.x); }
__global__ void __launch_bounds__(NTHR, 1) k_gemm2(Params p) { phase_gemm2(p, smem, blockIdx.x, gridDim.x, threadIdx.x); }
#endif

extern "C" void kernel_launch(void* const* d_in, const int* in_sizes, int n_in, void* d_out, int out_size, void* d_ws, size_t ws_size, hipStream_t stream) {
  Params p{};
  const float** pp = (const float**)&p;
  for (int i = 0; i < 24; ++i) pp[i] = (const float*)d_in[i];
  p.out = (float*)d_out; p.ws = (char*)d_ws;
  if (ws_size < WS_END) { fprintf(stderr, "workspace too small: %zu < %zu\n", ws_size, (size_t)WS_END); return; }
#if MK_LAUNCHES == 1
  static int grid_blocks = 0;
  if (!grid_blocks) {
    int dev = 0, cus = 0, per_cu = 0;
    hipGetDevice(&dev);
    hipDeviceGetAttribute(&cus, hipDeviceAttributeMultiprocessorCount, dev);
    hipFuncSetAttribute((const void*)mega_kernel, hipFuncAttributeMaxDynamicSharedMemorySize, LDS_BYTES);
    hipOccupancyMaxActiveBlocksPerMultiprocessor(&per_cu, mega_kernel, NTHR, LDS_BYTES);
    if (per_cu < 1) { fprintf(stderr, "occupancy query returned %d\n", per_cu); per_cu = 1; }
    if (per_cu > 1) per_cu = 1;
    grid_blocks = cus * per_cu;
  }
  (void)hipMemsetAsync((char*)d_ws + WS_CTRL, 0, 32768, stream);
  void* args[] = {&p};
  hipError_t e = hipLaunchCooperativeKernel((void*)mega_kernel, dim3(grid_blocks), dim3(NTHR), args, LDS_BYTES, stream);
  if (e != hipSuccess) fprintf(stderr, "cooperative launch failed: %s (grid %d)\n", hipGetErrorString(e), grid_blocks);
#else
  static int init = 0;
  if (!init) {
    hipFuncSetAttribute((const void*)k_prep, hipFuncAttributeMaxDynamicSharedMemorySize, LDS_BYTES);
    hipFuncSetAttribute((const void*)k_hpass, hipFuncAttributeMaxDynamicSharedMemorySize, LDS_BYTES);
    hipFuncSetAttribute((const void*)k_gemm1, hipFuncAttributeMaxDynamicSharedMemorySize, LDS_BYTES);
    hipFuncSetAttribute((const void*)k_attn, hipFuncAttributeMaxDynamicSharedMemorySize, LDS_BYTES);
    hipFuncSetAttribute((const void*)k_gemm2, hipFuncAttributeMaxDynamicSharedMemorySize, LDS_BYTES);
    init = 1;
  }
  k_prep<<<256, NTHR, LDS_BYTES, stream>>>(p);
  k_hpass<<<256, NTHR, LDS_BYTES, stream>>>(p);
  k_gemm1<<<256, NTHR, LDS_BYTES, stream>>>(p);
  k_attn<<<256, NTHR, LDS_BYTES, stream>>>(p);
  k_gemm2<<<256, NTHR, LDS_BYTES, stream>>>(p);
#endif
}
```

```cpp
#include <hip/hip_runtime.h>
#include <hip/hip_cooperative_groups.h>
#include <cstdio>
#include <cstdint>
namespace cg = cooperative_groups;

#ifndef PROBE
#define PROBE 0
#endif
#ifndef MK_LAUNCHES
#define MK_LAUNCHES 1
#endif

typedef short bf16x8 __attribute__((ext_vector_type(8)));
typedef short s16x4 __attribute__((ext_vector_type(4)));
typedef float f32x16 __attribute__((ext_vector_type(16)));
typedef float f32x4 __attribute__((ext_vector_type(4)));
typedef float f32x2 __attribute__((ext_vector_type(2)));
typedef __bf16 bf16x2_t __attribute__((ext_vector_type(2)));
typedef unsigned u32x4 __attribute__((ext_vector_type(4)));
typedef unsigned u32x2 __attribute__((ext_vector_type(2)));
#define LDSP __attribute__((address_space(3)))
#define DI __device__ __forceinline__
#define MFMA(a, b, c) __builtin_amdgcn_mfma_f32_32x32x16_bf16((a), (b), (c), 0, 0, 0)

constexpr int TP = 16384, TS = 512, T = TP + TS, DM = 1024, NU = 4096, WIN_LD = 4104;
constexpr int NTHR = 512;
constexpr float LOG2E = 1.4426950408889634f;
constexpr long O_Y = 0, O_YS = 16777216, O_AKP = 17301504, O_AVP = 25690112, O_BKP = 34078720, O_BVP = 42467328, O_LFP = 50855936,
               O_AKS = 50987008, O_AVS = 51249152, O_BKS = 51511296, O_BVS = 51773440, O_LFS = 52035584;
constexpr size_t al256(size_t x) { return (x + 255) / 256 * 256; }
constexpr size_t WS_CTRL = 0;
constexpr size_t WS_MOD = 32768;
constexpr size_t WS_MISC = al256(WS_MOD + 9 * 3072 * 4);
constexpr size_t WS_WFB = WS_MISC + 256;
constexpr size_t WS_ITEMS = WS_WFB + 8 * 1024 * 4;
constexpr size_t WS_CUMP = WS_ITEMS + 2048 * 4;
constexpr size_t WS_CUMS = WS_CUMP + 8 * 16384 * 4;
constexpr size_t WS_LOGF = al256(WS_CUMS + 64 * 1088 * 4);
constexpr size_t WS_WTIN = al256(WS_LOGF + (size_t)T * 8 * 4);
constexpr size_t WS_WTOUT = WS_WTIN + (size_t)4096 * 1024 * 2;
constexpr size_t WS_CAK = WS_WTOUT + (size_t)1024 * 1024 * 2;
constexpr size_t WS_CAV = WS_CAK + (size_t)8 * 1024 * 512 * 2;
constexpr size_t WS_CBK = WS_CAV + (size_t)8 * 1024 * 512 * 2;
constexpr size_t WS_CBV = WS_CBK + (size_t)8 * 1024 * 512 * 2;
constexpr size_t WS_H = WS_CBV + (size_t)8 * 1024 * 512 * 2;
constexpr size_t WS_U = WS_H + (size_t)T * 1024 * 2;
constexpr size_t WS_END = WS_U + (size_t)T * 4096 * 2;
constexpr int N_ITEMS = 1120;
constexpr int LDS_BYTES = 112640;

struct Params {
  const float *x_prompt, *x_sample, *cache_a_k, *cache_a_v, *cache_b_k, *cache_b_v, *cache_b_logf, *c_prompt, *c_sample,
      *norm_g, *w_ada, *b_ada, *w_in, *b_f, *qn_a, *kn_a, *lam_q1, *lam_k1, *lam_q2, *lam_k2, *subln_g, *qn_b, *kn_b, *w_out;
  float* out; char* ws;
};

DI unsigned pk2(float a, float b) { f32x2 v = {a, b}; bf16x2_t r = __builtin_convertvector(v, bf16x2_t); return __builtin_bit_cast(unsigned, r); }
DI bf16x8 pk8(float a, float b, float c, float d, float e, float f, float g, float h) { u32x4 w = {pk2(a, b), pk2(c, d), pk2(e, f), pk2(g, h)}; return __builtin_bit_cast(bf16x8, w); }
DI float bf2f(unsigned short v) { return __uint_as_float(((unsigned)v) << 16); }
DI float wave_sum(float v) {
#pragma unroll
  for (int o = 32; o > 0; o >>= 1) v += __shfl_xor(v, o);
  return v;
}
DI float wave_max(float v) {
#pragma unroll
  for (int o = 32; o > 0; o >>= 1) v = fmaxf(v, __shfl_xor(v, o));
  return v;
}
DI int crow0(int r) { return (r & 3) + 8 * (r >> 2); }
DI float silu_f(float z) { return z / (1.f + __expf(-z)); }
DI s16x4 tr_read(unsigned lds_addr) { return __builtin_amdgcn_ds_read_tr16_b64_v4i16((LDSP s16x4*)lds_addr); }

constexpr int J_MOD = 96, J_MISC = 1, J_WIN = 1024, J_WOUT = 256, J_CVT = 256;
constexpr int J_TOTAL = J_MOD + J_MISC + J_WIN + J_WOUT + J_CVT;

DI void prep_mod_job(const Params& p, char* lds, int job, int tid) {
  float* sc = (float*)lds;
  float* red = (float*)(lds + 9 * 1024 * 4);
  for (int i = tid; i < 9 * 1024; i += NTHR) { const int b = i >> 10, k = i & 1023; const float c = b == 0 ? p.c_prompt[k] : p.c_sample[(b - 1) * 1024 + k]; sc[i] = c / (1.f + expf(-c)); }
  __syncthreads();
  const int c = tid & 31, kq = tid >> 5, n = job * 32 + c;
  float acc[9];
#pragma unroll
  for (int b = 0; b < 9; ++b) acc[b] = 0.f;
  const float* wp = p.w_ada + (size_t)(kq * 64) * 3072 + n;
#pragma unroll 8
  for (int k = 0; k < 64; ++k) {
    const float w = wp[(size_t)k * 3072];
#pragma unroll
    for (int b = 0; b < 9; ++b) acc[b] += sc[b * 1024 + kq * 64 + k] * w;
  }
#pragma unroll
  for (int b = 0; b < 9; ++b) red[(kq * 9 + b) * 32 + c] = acc[b];
  __syncthreads();
  for (int i = tid; i < 9 * 32; i += NTHR) {
    const int b = i >> 5, cc = i & 31; float s = 0.f;
#pragma unroll
    for (int q = 0; q < 16; ++q) s += red[(q * 9 + b) * 32 + cc];
    ((float*)(p.ws + WS_MOD))[b * 3072 + job * 32 + cc] = s + p.b_ada[job * 32 + cc];
  }
  __syncthreads();
}

DI int item_cost(int e) { if (e < 512) return 3 * (2 * (e >> 2) + 2); if (e < 1024) return 2 * (4 * ((e - 512) >> 3) + 4); if (e < 1056) return 51; return 34; }
DI int item_code(int e) {
  if (e < 512) return (0 << 16) | ((e & 3) << 8) | (e >> 2);
  if (e < 1024) { e -= 512; return (1 << 16) | ((e & 7) << 8) | (e >> 3); }
  if (e < 1056) { e -= 1024; return (2 << 16) | ((e & 3) << 8) | (e >> 2); }
  e -= 1056; return (3 << 16) | ((e & 7) << 8) | (e >> 3);
}

DI void prep_misc_job(const Params& p, char* lds, int tid) {
  float* misc = (float*)(p.ws + WS_MISC);
  const int w = tid >> 6, l = tid & 63;
  if (w == 0) {
    const float s1 = wave_sum(p.lam_q1[l] * p.lam_k1[l]), s2 = wave_sum(p.lam_q2[l] * p.lam_k2[l]);
    if (l == 0) misc[0] = expf(s1) - expf(s2) + 0.2f;
  } else if (w == 1) {
    const float a = wave_max(fabsf(p.qn_a[l])), b = wave_max(fabsf(p.kn_a[l]));
    if (l == 0) misc[1] = 8.f * a * b * LOG2E * 1.02f;
  } else if (w == 2) {
    const float a = wave_max(fabsf(p.qn_b[l])), b = wave_max(fabsf(p.kn_b[l]));
    if (l == 0) misc[2] = 8.f * a * b * LOG2E * 1.02f;
  }
  float* wfb = (float*)(p.ws + WS_WFB);
  for (int i = tid; i < 8192; i += NTHR) { const int k = i >> 3, j = i & 7; wfb[j * 1024 + k] = p.w_in[(size_t)k * WIN_LD + 3584 + j]; }
  __syncthreads();
}

DI void prep_tr_job(const float* src, int ld, short* dst, char* lds, int tid) {
  float* tile = (float*)lds;
#pragma unroll
  for (int i = 0; i < 8; ++i) { const int e = tid + NTHR * i, r = e >> 6, c = e & 63; tile[r * 65 + c] = src[(size_t)r * ld + c]; }
  __syncthreads();
  const int n = tid >> 3, kc = tid & 7;
  float v[8];
#pragma unroll
  for (int i = 0; i < 8; ++i) v[i] = tile[(kc * 8 + i) * 65 + n];
  *(bf16x8*)(dst + (size_t)n * 1024 + kc * 8) = pk8(v[0], v[1], v[2], v[3], v[4], v[5], v[6], v[7]);
  __syncthreads();
}

constexpr int J_HEAD = J_MOD + J_MISC + J_WIN;
DI void phase_prep(const Params& p, char* lds, int job_begin, int job_end, int start, int stride, int tid) {
  for (int job = job_begin + start; job < job_end; job += stride) {
    int j = job;
    if (j < J_MOD) { prep_mod_job(p, lds, j, tid); continue; }
    j -= J_MOD;
    if (j < J_MISC) { prep_misc_job(p, lds, tid); continue; }
    j -= J_MISC;
    if (j < J_WIN) { const int kt = j >> 6, nt = j & 63; const int n0 = nt * 64, sn0 = n0 < 3584 ? n0 : n0 + 8;
      prep_tr_job(p.w_in + (size_t)(kt * 64) * WIN_LD + sn0, WIN_LD, (short*)(p.ws + WS_WTIN) + (size_t)n0 * 1024 + kt * 64, lds, tid); continue; }
    j -= J_WIN;
    if (j < J_WOUT) { const int kt = j >> 4, nt = j & 15;
      prep_tr_job(p.w_out + (size_t)(kt * 64) * 1024 + nt * 64, 1024, (short*)(p.ws + WS_WTOUT) + (size_t)(nt * 64) * 1024 + kt * 64, lds, tid); continue; }
    j -= J_WOUT;
    { const int which = j >> 6, part = j & 63;
      const float* src = which == 0 ? p.cache_a_k : which == 1 ? p.cache_a_v : which == 2 ? p.cache_b_k : p.cache_b_v;
      short* dst = (short*)(p.ws + (which == 0 ? WS_CAK : which == 1 ? WS_CAV : which == 2 ? WS_CBK : WS_CBV));
      const size_t base = (size_t)part * 65536;
#pragma unroll 4
      for (int i = 0; i < 16; ++i) { const size_t o = base + (size_t)(i * NTHR + tid) * 8; const f32x4 a = *(const f32x4*)(src + o), b = *(const f32x4*)(src + o + 4);
        *(bf16x8*)(dst + o) = pk8(a[0], a[1], a[2], a[3], b[0], b[1], b[2], b[3]); } }
  }
}

DI void phase_hpass(const Params& p, char* lds, int bid, int nb, int tid) {
  float* wfb_s = (float*)lds;
  for (int i = tid; i < 2048; i += NTHR) ((f32x4*)wfb_s)[i] = ((const f32x4*)(p.ws + WS_WFB))[i];
  __syncthreads();
  const int w = tid >> 6, l = tid & 63;
  const float* modp = (const float*)(p.ws + WS_MOD);
  short* H = (short*)(p.ws + WS_H);
  float* logf_ws = (float*)(p.ws + WS_LOGF);
  int cur_b = -1; f32x4 ga[4], sb[4];
#pragma unroll
  for (int i = 0; i < 4; ++i) { ga[i] = (f32x4){0.f, 0.f, 0.f, 0.f}; sb[i] = ga[i]; }
  for (int tok = bid * 8 + w; tok < T; tok += nb * 8) {
    const bool pr = tok < TP;
    const float* xr = pr ? p.x_prompt + (size_t)tok * 1024 : p.x_sample + (size_t)(tok - TP) * 1024;
    const int bidx = pr ? 0 : 1 + ((tok - TP) >> 6);
    if (bidx != cur_b) { cur_b = bidx; const float* md = modp + bidx * 3072;
#pragma unroll
      for (int i = 0; i < 4; ++i) { const int c = i * 256 + l * 4; const f32x4 g = *(const f32x4*)(p.norm_g + c), scl = *(const f32x4*)(md + 1024 + c); ga[i] = g * (1.f + scl); sb[i] = *(const f32x4*)(md + c); } }
    f32x4 xv[4]; float ss = 0.f;
#pragma unroll
    for (int i = 0; i < 4; ++i) { xv[i] = *(const f32x4*)(xr + i * 256 + l * 4); ss += xv[i][0] * xv[i][0] + xv[i][1] * xv[i][1] + xv[i][2] * xv[i][2] + xv[i][3] * xv[i][3]; }
    ss = wave_sum(ss);
    const float rstd = rsqrtf(ss * (1.f / 1024.f) + 1e-6f);
    float fb[8];
#pragma unroll
    for (int j = 0; j < 8; ++j) fb[j] = 0.f;
#pragma unroll
    for (int i = 0; i < 4; ++i) {
      const int c = i * 256 + l * 4;
      f32x4 hv;
#pragma unroll
      for (int e = 0; e < 4; ++e) hv[e] = (xv[i][e] * rstd) * ga[i][e] + sb[i][e];
      u32x2 hw = {pk2(hv[0], hv[1]), pk2(hv[2], hv[3])};
      *(u32x2*)(H + (size_t)tok * 1024 + c) = hw;
#pragma unroll
      for (int j = 0; j < 8; ++j) { const f32x4 wv = *(const f32x4*)(wfb_s + j * 1024 + c); fb[j] += hv[0] * wv[0] + hv[1] * wv[1] + hv[2] * wv[2] + hv[3] * wv[3]; }
    }
#pragma unroll
    for (int i = 0; i < 4; ++i) { const float send = (l & 1) ? fb[i] : fb[i + 4], keep = (l & 1) ? fb[i + 4] : fb[i]; fb[i] = keep + __shfl_xor(send, 1); }
#pragma unroll
    for (int i = 0; i < 2; ++i) { const float send = (l & 2) ? fb[i] : fb[i + 2], keep = (l & 2) ? fb[i + 2] : fb[i]; fb[i] = keep + __shfl_xor(send, 2); }
    { const float send = (l & 4) ? fb[0] : fb[1], keep = (l & 4) ? fb[1] : fb[0]; fb[0] = keep + __shfl_xor(send, 4); }
    float v = fb[0];
    v += __shfl_xor(v, 8); v += __shfl_xor(v, 16); v += __shfl_xor(v, 32);
    const int jl = ((l >> 2) & 1) + 2 * ((l >> 1) & 1) + 4 * (l & 1);
    if (l < 8) {
      const float z = v + p.b_f[jl];
      const float lf = fminf(z, 0.f) - log1pf(expf(-fabsf(z)));
      logf_ws[(size_t)tok * 8 + jl] = lf;
      if (pr) p.out[O_LFP + (size_t)tok * 8 + jl] = lf; else p.out[O_LFS + (size_t)(tok - TP) * 8 + jl] = lf;
    }
  }
  __syncthreads();
}

DI float block_excl_scan(float v, float* sm, int tid) {
  const int w = tid >> 6, l = tid & 63;
  float inc = v;
#pragma unroll
  for (int o = 1; o < 64; o <<= 1) { const float t = __shfl_up(inc, o); if (l >= o) inc += t; }
  if (l == 63) sm[w] = inc;
  __syncthreads();
  float pre = 0.f;
#pragma unroll
  for (int i = 0; i < 8; ++i) pre += (i < w) ? sm[i] : 0.f;
  __syncthreads();
  return pre + inc - v;
}
DI void scan_job(const Params& p, char* lds, int job, int tid) {
  float* sm = (float*)lds;
  const float* logf_ws = (const float*)(p.ws + WS_LOGF);
  if (job < 8) {
    const int hh = job; float* cum = (float*)(p.ws + WS_CUMP) + hh * 16384;
    float vals[32]; float s = 0.f;
#pragma unroll
    for (int i = 0; i < 32; ++i) { vals[i] = logf_ws[(size_t)(tid * 32 + i) * 8 + hh]; s += vals[i]; }
    float run = block_excl_scan(s, sm, tid);
#pragma unroll
    for (int i = 0; i < 32; ++i) { run += vals[i]; cum[tid * 32 + i] = run; }
  } else {
    const int bh = job - 8, b = bh >> 3, hh = bh & 7; float* cum = (float*)(p.ws + WS_CUMS) + bh * 1088;
    float vals[3]; float s = 0.f;
#pragma unroll
    for (int i = 0; i < 3; ++i) { const int k = tid * 3 + i; float v = 0.f;
      if (k < 1024) v = p.cache_b_logf[(size_t)(b * 1024 + k) * 8 + hh]; else if (k < 1088) v = logf_ws[(size_t)(TP + b * 64 + (k - 1024)) * 8 + hh];
      vals[i] = v; s += v; }
    float run = block_excl_scan(s, sm, tid);
#pragma unroll
    for (int i = 0; i < 3; ++i) { const int k = tid * 3 + i; run += vals[i]; if (k < 1088) cum[k] = run; }
  }
}

template <int NBW>
DI void gemm_main(const short* __restrict__ Ag, const short* __restrict__ Bg, char* lds, f32x16 (&acc)[2][NBW], int tid) {
  constexpr int STAGE = 16384 + 16384 * NBW;
  const int w = __builtin_amdgcn_readfirstlane(tid >> 6), l = tid & 63, r32 = l & 31, h = l >> 5, wa = w & 1, wb = w >> 1;
  const int gch = (l & 7) ^ (((l >> 4) + 4 * w) & 7);
  const short* agl = Ag + (size_t)(8 * w + (l >> 3)) * 1024 + gch * 8;
  const short* bgl = Bg + (size_t)(8 * w + (l >> 3)) * 1024 + gch * 8;
  const unsigned lds0 = (unsigned)(uintptr_t)lds + (unsigned)w * 1024u;
#pragma unroll
  for (int ab = 0; ab < 2; ++ab)
#pragma unroll
    for (int bb = 0; bb < NBW; ++bb)
#pragma unroll
      for (int r = 0; r < 16; ++r) acc[ab][bb][r] = 0.f;
#define G_DMA(kt, st) do { const unsigned b_ = lds0 + (unsigned)((st) * STAGE); \
    _Pragma("unroll") for (int i = 0; i < 2; ++i) __builtin_amdgcn_global_load_lds((const unsigned*)(agl + (size_t)i * 64 * 1024 + (kt) * 64), (LDSP unsigned*)(b_ + i * 8192), 16, 0, 0); \
    _Pragma("unroll") for (int i = 0; i < 2 * NBW; ++i) __builtin_amdgcn_global_load_lds((const unsigned*)(bgl + (size_t)i * 64 * 1024 + (kt) * 64), (LDSP unsigned*)(b_ + 16384 + i * 8192), 16, 0, 0); } while (0)
  G_DMA(0, 0);
  asm volatile("s_waitcnt vmcnt(0)" ::: "memory");
  __syncthreads();
  const int fswz = (r32 >> 1) & 7;
  const int aoff = (wa * 64 + r32) * 128, boff = 16384 + (wb * 32 * NBW + r32) * 128;
  for (int kt = 0; kt < 16; ++kt) {
    if (kt < 15) G_DMA(kt + 1, (kt + 1) & 1);
    const char* base = lds + (kt & 1) * STAGE;
#pragma unroll
    for (int ks = 0; ks < 4; ++ks) {
      const int co = ((2 * ks + h) ^ fswz) << 4;
      bf16x8 af[2], bf[NBW];
#pragma unroll
      for (int ab = 0; ab < 2; ++ab) af[ab] = *(const bf16x8*)(base + aoff + ab * 4096 + co);
#pragma unroll
      for (int bb = 0; bb < NBW; ++bb) bf[bb] = *(const bf16x8*)(base + boff + bb * 4096 + co);
      __builtin_amdgcn_s_setprio(1);
#pragma unroll
      for (int ab = 0; ab < 2; ++ab)
#pragma unroll
        for (int bb = 0; bb < NBW; ++bb) acc[ab][bb] = MFMA(af[ab], bf[bb], acc[ab][bb]);
      __builtin_amdgcn_s_setprio(0);
    }
    asm volatile("s_waitcnt vmcnt(0)" ::: "memory");
    __syncthreads();
  }
#undef G_DMA
}

DI void store4(float* of, short* ub, float a, float b, float c, float d) {
  if (of) { f32x4 v = {a, b, c, d}; *(f32x4*)of = v; }
  u32x2 w = {pk2(a, b), pk2(c, d)}; *(u32x2*)ub = w;
}
DI void phase_gemm1(const Params& p, char* lds, int bid, int nb, int tid) {
  const int w = __builtin_amdgcn_readfirstlane(tid >> 6), l = tid & 63, r32 = l & 31, h = l >> 5, wa = w & 1, wb = w >> 1;
  const short* Wt = (const short*)(p.ws + WS_WTIN);
  const short* H = (const short*)(p.ws + WS_H);
  short* U = (short*)(p.ws + WS_U);
  char* scr = lds + w * 12288;
  constexpr int SP = 272;
  const bool xmap = (nb & 7) == 0;
  const int xq = bid & 7, jl = bid >> 3, nbx = nb >> 3;
  for (int it = 0;; ++it) {
    int mt, nt;
    if (xmap) { const int t = it * nbx + jl; if (t >= 33 * 8) break; mt = 2 * (t >> 3) + (xq >> 2); nt = 8 * (xq & 3) + (t & 7); }
    else { const int tile = it * nb + bid; if (tile >= 66 * 32) break; mt = tile >> 5; nt = tile & 31; }
    f32x16 acc[2][2];
    gemm_main<2>(Wt + (size_t)nt * 128 * 1024, H + (size_t)mt * 256 * 1024, lds, acc, tid);
    const int n0 = nt * 128 + wa * 64, g = n0 >> 6, seg = g >> 3, gi = g & 7;
    const bool norm = (seg == 0 || seg == 1 || seg == 4 || seg == 5), rope = seg < 2, silu = (seg == 3 || seg == 7);
    const float* gain = seg == 0 ? p.qn_a : seg == 1 ? p.kn_a : seg == 4 ? p.qn_b : p.kn_b;
    const float qscale = (seg == 0 || seg == 4) ? 0.125f * LOG2E : 1.f;
    long obase = -1;
    const bool prm = mt < 64;
    if (seg == 1) obase = prm ? O_AKP : O_AKS; else if (seg == 2) obase = prm ? O_AVP : O_AVS; else if (seg == 5) obase = prm ? O_BKP : O_BKS; else if (seg == 6) obase = prm ? O_BVP : O_BVS;
    const int ocol = gi * 64;
#pragma unroll
    for (int bb = 0; bb < 2; ++bb) {
      const int tok0 = mt * 256 + wb * 64 + bb * 32;
      const int tok = tok0 + r32;
      float rstd = 1.f;
      if (norm) {
        float ss = 0.f;
#pragma unroll
        for (int ab = 0; ab < 2; ++ab)
#pragma unroll
          for (int r = 0; r < 16; ++r) ss += acc[ab][bb][r] * acc[ab][bb][r];
        ss += __shfl_xor(ss, 32);
        rstd = rsqrtf(ss * (1.f / 64.f) + 1e-6f);
      }
      float cs[4], sn[4];
      if (rope) {
        const int pos = prm ? tok : 1024 + ((tok - TP) & 63);
#pragma unroll
        for (int r = 0; r < 4; ++r) {
          const int i = 4 * h + r;
          const double inv = i == 0 ? 0.15915494309189535 : i == 1 ? 0.03086376340470123 : i == 2 ? 0.005985185712713705 : i == 3 ? 0.001160663641240061 : i == 4 ? 0.00022507907903927653 : i == 5 ? 4.364795279280289e-05 : i == 6 ? 8.464330808241401e-06 : 1.6414262627950345e-06;
          double rev = (double)pos * inv;
          rev -= rint(rev);
          const float revf = (float)rev;
          cs[r] = __builtin_amdgcn_cosf(revf); sn[r] = __builtin_amdgcn_sinf(revf);
        }
      }
#pragma unroll
      for (int ab = 0; ab < 2; ++ab) {
        float v[16];
#pragma unroll
        for (int r = 0; r < 16; ++r) v[r] = acc[ab][bb][r];
        if (norm) {
#pragma unroll
          for (int rq = 0; rq < 4; ++rq) { const f32x4 gv = *(const f32x4*)(gain + ab * 32 + 8 * rq + 4 * h);
#pragma unroll
            for (int e = 0; e < 4; ++e) v[4 * rq + e] = v[4 * rq + e] * rstd * gv[e]; }
        }
        if (rope && ab == 0) {
#pragma unroll
          for (int r = 0; r < 4; ++r) { const float x1 = v[r], x2 = v[r + 4]; v[r] = x1 * cs[r] - x2 * sn[r]; v[r + 4] = x2 * cs[r] + x1 * sn[r]; }
        }
#pragma unroll
        for (int rq = 0; rq < 4; ++rq) {
          float a0 = v[4 * rq], a1 = v[4 * rq + 1], a2 = v[4 * rq + 2], a3 = v[4 * rq + 3];
          if (silu) { a0 = silu_f(a0); a1 = silu_f(a1); a2 = silu_f(a2); a3 = silu_f(a3); }
          const f32x4 vv = {a0, a1, a2, a3};
          *(f32x4*)(scr + r32 * SP + (ab * 32 + 8 * rq + 4 * h) * 4) = vv;
        }
      }
      const int orow0 = prm ? tok0 : tok0 - TP;
      if (obase >= 0) {
#pragma unroll
        for (int i = 0; i < 8; ++i) {
          const int row = 4 * i + (l >> 4);
          const f32x4 vv = *(const f32x4*)(scr + row * SP + (l & 15) * 16);
          *(f32x4*)(p.out + obase + (size_t)(orow0 + row) * 512 + ocol + (l & 15) * 4) = vv;
        }
      }
#pragma unroll
      for (int i = 0; i < 4; ++i) {
        const int row = 8 * i + (l >> 3);
        const f32x4 va = *(const f32x4*)(scr + row * SP + (l & 7) * 32), vb = *(const f32x4*)(scr + row * SP + (l & 7) * 32 + 16);
        *(bf16x8*)(U + (size_t)(tok0 + row) * 4096 + n0 + (l & 7) * 8) = pk8(va[0] * qscale, va[1] * qscale, va[2] * qscale, va[3] * qscale, vb[0] * qscale, vb[1] * qscale, vb[2] * qscale, vb[3] * qscale);
      }
    }
    __syncthreads();
  }
}


template <bool ISB> struct AC {
  static constexpr int KP = ISB ? 128 : 256, VP = ISB ? 192 : 320, NDB = ISB ? 2 : 4;
  static constexpr int KT = 64 * KP, VT = 64 * VP, CKB = ISB ? 256 : 0, SLOT = KT + VT + CKB;
};

template <bool ISB, bool FAST>
DI void attn_step(char* lds, unsigned lds0, int kslot, int hk, int vslot, int hv, int hu, bool doQK, bool doExp, bool doPV, bool mask,
                  const bf16x8 (&qf)[4], const f32x16& initC, float cqp, int qm, int koff_lane, int cbase, int kswz, unsigned vbase, int h,
                  const f32x16& Sc, f32x16& Sn, bf16x8 (&pf)[2], f32x16 (&O)[AC<ISB>::NDB], float& lsum) {
  typedef AC<ISB> C;
  bf16x8 kf[4];
#pragma unroll
  for (int r = 0; r < 16; ++r) Sn[r] = 0.f;
  if (FAST || doQK) {
    const char* kb = lds + kslot + hk * 32 * C::KP + koff_lane;
#pragma unroll
    for (int ks = 0; ks < 4; ++ks) kf[ks] = *(const bf16x8*)(kb + (((cbase + 2 * ks) ^ kswz) << 4));
    if (ISB) {
      const float* ck = (const float*)(lds + kslot + C::KT + C::VT) + hk * 32 + 4 * h;
#pragma unroll
      for (int rq = 0; rq < 4; ++rq) { const f32x4 c0 = *(const f32x4*)(ck + 8 * rq);
#pragma unroll
        for (int e = 0; e < 4; ++e) Sn[4 * rq + e] = cqp - c0[e]; }
    }
  }
  const unsigned va = lds0 + vslot + C::KT + vbase + hv * 32 * C::VP;
  bf16x8 vf0[C::NDB];
  if (FAST || doPV) {
#pragma unroll
    for (int db = 0; db < C::NDB; ++db) {
      const s16x4 t0 = tr_read(va + 64 * db), t1 = tr_read(va + 8 * C::VP + 64 * db);
      vf0[db] = __builtin_shufflevector(t0, t1, 0, 1, 2, 3, 4, 5, 6, 7);
    }
  }
  if (FAST) __builtin_amdgcn_s_setprio(1);
  if (FAST || doQK) {
#pragma unroll
    for (int ks = 0; ks < 4; ++ks) Sn = MFMA(kf[ks], qf[ks], Sn);
  }
  if (FAST || doPV) {
    bf16x8 vf1[C::NDB];
#pragma unroll
    for (int db = 0; db < C::NDB; ++db) {
      const s16x4 t0 = tr_read(va + 16 * C::VP + 64 * db), t1 = tr_read(va + 24 * C::VP + 64 * db);
      vf1[db] = __builtin_shufflevector(t0, t1, 0, 1, 2, 3, 4, 5, 6, 7);
    }
#pragma unroll
    for (int db = 0; db < C::NDB; ++db) O[db] = MFMA(vf0[db], pf[0], O[db]);
#pragma unroll
    for (int db = 0; db < C::NDB; ++db) O[db] = MFMA(vf1[db], pf[1], O[db]);
  }
  if (FAST || doExp) {
    f32x16 pv = Sc;
    if (!FAST && ISB && mask) {
      const int qmh = qm - 32 * hu;
#pragma unroll
      for (int r = 0; r < 16; ++r) if (crow0(r) > qmh) pv[r] = -INFINITY;
    }
#pragma unroll
    for (int r = 0; r < 16; ++r) pv[r] = __builtin_amdgcn_exp2f(pv[r]);
    float s0 = (pv[0] + pv[1]) + (pv[2] + pv[3]), s1 = (pv[4] + pv[5]) + (pv[6] + pv[7]), s2 = (pv[8] + pv[9]) + (pv[10] + pv[11]), s3 = (pv[12] + pv[13]) + (pv[14] + pv[15]);
    lsum += (s0 + s1) + (s2 + s3);
    pf[0] = pk8(pv[0], pv[1], pv[2], pv[3], pv[4], pv[5], pv[6], pv[7]);
    pf[1] = pk8(pv[8], pv[9], pv[10], pv[11], pv[12], pv[13], pv[14], pv[15]);
  }
  if (FAST) __builtin_amdgcn_s_setprio(0);
}

template <bool ISB>
DI void attn_item(const Params& p, char* lds, bool sample, int hh, int idx, int tid_in) {
  typedef AC<ISB> C;
  int tid = tid_in; asm volatile("" : "+v"(tid));
  const int w = tid >> 6, l = tid & 63, r32 = l & 31, h = l >> 5;
  const int qs = ISB ? w : (w >> 1), j = ISB ? 0 : (w & 1);
  const short* U = (const short*)(p.ws + WS_U);
  const float* misc = (const float*)(p.ws + WS_MISC);
  const float lam = misc[0], CS = ISB ? misc[2] : misc[1];
  constexpr int QCOL = ISB ? 2048 : 0, KCOL = ISB ? 2560 : 512, ZCOL = ISB ? 3584 : 1536, HW = ISB ? 64 : 128, NH = ISB ? 8 : 4;
  int nt, chunk; size_t qtok; const float* cum = nullptr; float cq = 0.f;
  if (!sample) {
    if (ISB) { nt = 4 * idx + 4; chunk = 4 * idx + (w >> 1); qtok = (size_t)idx * 256 + w * 32 + r32; cum = (const float*)(p.ws + WS_CUMP) + hh * 16384; cq = cum[qtok]; }
    else { nt = 2 * idx + 2; chunk = 2 * idx + (qs >> 1); qtok = (size_t)idx * 128 + qs * 32 + r32; }
  } else {
    nt = 17; chunk = qs < 2 ? 16 : -1; qtok = (size_t)TP + idx * 64 + (qs & 1) * 32 + r32;
    if (ISB) { cum = (const float*)(p.ws + WS_CUMS) + (idx * 8 + hh) * 1088; cq = cum[1024 + (qs & 1) * 32 + r32]; }
  }
  int kt0 = 0;
  if (ISB) {
    const int qfirst = sample ? 1024 : idx * 256;
    const float cqf = cum[qfirst] * LOG2E;
    const int pred = (tid < nt - 4) && (cqf - cum[64 * tid + 63] * LOG2E < -170.f);
    kt0 = __syncthreads_count(pred);
    nt -= kt0; if (chunk >= 0) chunk -= kt0;
  }
  const int umax = 2 * chunk + 1;
  const float cqp = cq * LOG2E - CS;
  const int qm = (qs & 1) * 32 + r32 - 4 * h;
  bf16x8 qf[4];
#pragma unroll
  for (int ks = 0; ks < 4; ++ks) qf[ks] = *(const bf16x8*)(U + qtok * 4096 + QCOL + hh * HW + j * 64 + ks * 16 + h * 8);
  f32x16 O[C::NDB];
#pragma unroll
  for (int db = 0; db < C::NDB; ++db)
#pragma unroll
    for (int r = 0; r < 16; ++r) O[db][r] = 0.f;
  f32x16 initC;
#pragma unroll
  for (int r = 0; r < 16; ++r) initC[r] = -CS;
  float lsum = 0.f;
  constexpr int NCH = ISB ? 1 : 2;
  const int srow = ISB ? (tid >> 3) : (tid >> 4), sch = ISB ? (tid & 7) : (tid & 15);
  const int k_st = ISB ? srow * 128 + ((sch ^ ((srow >> 1) & 7)) << 4) : srow * 256 + ((sch ^ (srow & 15)) << 4);
  const int v_st = C::KT + srow * C::VP + sch * 16;
  u32x4 rk[NCH], rv[NCH]; f32x4 rc = {0.f, 0.f, 0.f, 0.f};
  const short* cache_k = (const short*)(p.ws + (ISB ? WS_CBK : WS_CAK));
  const short* cache_v = (const short*)(p.ws + (ISB ? WS_CBV : WS_CAV));
#define KV_PTR(ktr, kp_, vp_, pitch_) const short *kp_, *vp_; size_t pitch_; const int kt_ = (ktr) + kt0; \
    if (!sample) { kp_ = U + (size_t)(kt_ * 64) * 4096 + KCOL + hh * HW; vp_ = kp_ + 512; pitch_ = 4096; } \
    else if (kt_ < 16) { const size_t o_ = ((size_t)(idx * 1024 + kt_ * 64) * NH + hh) * HW; kp_ = cache_k + o_; vp_ = cache_v + o_; pitch_ = 512; } \
    else { kp_ = U + (size_t)(TP + idx * 64) * 4096 + KCOL + hh * HW; vp_ = kp_ + 512; pitch_ = 4096; }
#define LOAD_K(kt) do { KV_PTR(kt, kp_, vp_, pitch_); (void)vp_; _Pragma("unroll") for (int i = 0; i < NCH; ++i) rk[i] = *(const u32x4*)(kp_ + (size_t)(srow + 32 * i) * pitch_ + sch * 8); \
    if (ISB && tid < 16) rc = *(const f32x4*)(cum + ((kt) + kt0) * 64 + tid * 4); } while (0)
#define LOAD_V(kt) do { KV_PTR(kt, kp_, vp_, pitch_); (void)kp_; _Pragma("unroll") for (int i = 0; i < NCH; ++i) rv[i] = *(const u32x4*)(vp_ + (size_t)(srow + 32 * i) * pitch_ + sch * 8); } while (0)
#define STORE_K(slot) do { char* b_ = lds + (slot); _Pragma("unroll") for (int i = 0; i < NCH; ++i) *(u32x4*)(b_ + k_st + i * 32 * C::KP) = rk[i]; \
    if (ISB && tid < 16) { const f32x4 t_ = rc * LOG2E; *(f32x4*)(b_ + C::KT + C::VT + tid * 16) = t_; } } while (0)
#define STORE_V(slot) do { char* b_ = lds + (slot); _Pragma("unroll") for (int i = 0; i < NCH; ++i) *(u32x4*)(b_ + v_st + i * 32 * C::VP) = rv[i]; } while (0)
  const unsigned lds0 = (unsigned)(uintptr_t)lds;
  const unsigned vbase = (4 * h + ((l & 15) >> 2)) * C::VP + (16 * ((l >> 4) & 1) + 4 * (l & 3)) * 2;
  const int kswz = ISB ? ((r32 >> 1) & 7) : (r32 & 15);
  const int koff_lane = r32 * C::KP, cbase = j * 8 + h;
  LOAD_K(0); LOAD_V(0); STORE_K(0); STORE_V(0);
  LOAD_K(1); STORE_K(C::SLOT);
  __syncthreads();
  f32x16 Sa = initC, Sb = initC; bf16x8 pf[2] = {};
  if (umax >= 0) attn_step<ISB, false>(lds, lds0, 0, 0, 0, 0, 0, true, false, false, false, qf, initC, cqp, qm, koff_lane, cbase, kswz, vbase, h, Sb, Sa, pf, O, lsum);
  int s0 = 0, s1 = C::SLOT, s2 = 2 * C::SLOT;
  for (int kt = 0; kt < nt; ++kt) {
    if (kt + 2 < nt) LOAD_K(kt + 2);
    if (kt + 1 < nt) LOAD_V(kt + 1);
#define HSTEP(hf, SIN, SOUT) do { const int u = 2 * kt + (hf); \
      const bool doQK = u + 1 <= umax, doExp = u <= umax, doPV = u >= 1 && u - 1 <= umax; \
      const bool mask = ISB && u >= 2 * chunk; \
      const int kslot = (hf) == 0 ? s0 : s1, hk = (hf) == 0 ? 1 : 0, vslot = (hf) == 0 ? s2 : s0, hv = (hf) == 0 ? 1 : 0; \
      if (doQK && doPV && !mask) attn_step<ISB, true>(lds, lds0, kslot, hk, vslot, hv, (hf), true, true, true, false, qf, initC, cqp, qm, koff_lane, cbase, kswz, vbase, h, SIN, SOUT, pf, O, lsum); \
      else if (doExp || doPV) attn_step<ISB, false>(lds, lds0, kslot, hk, vslot, hv, (hf), doQK, doExp, doPV, mask, qf, initC, cqp, qm, koff_lane, cbase, kswz, vbase, h, SIN, SOUT, pf, O, lsum); } while (0)
    HSTEP(0, Sa, Sb);
    HSTEP(1, Sb, Sa);
#undef HSTEP
    if (kt + 2 < nt) STORE_K(s2);
    if (kt + 1 < nt) STORE_V(s1);
    __syncthreads();
    const int t_ = s0; s0 = s1; s1 = s2; s2 = t_;
  }
  if (umax == 2 * nt - 1) attn_step<ISB, false>(lds, lds0, 0, 0, s2, 1, 0, false, false, true, false, qf, initC, cqp, qm, koff_lane, cbase, kswz, vbase, h, Sa, Sb, pf, O, lsum);
#undef KV_PTR
#undef LOAD_K
#undef LOAD_V
#undef STORE_K
#undef STORE_V
  __syncthreads();
  lsum += __shfl_xor(lsum, 32);
  const float rl = 1.f / lsum;
  short* G = (short*)(p.ws + WS_H);
  if (ISB) {
    if (umax >= 0) {
#pragma unroll
      for (int db = 0; db < C::NDB; ++db)
#pragma unroll
        for (int rq = 0; rq < 4; ++rq) {
          const int d = db * 32 + 8 * rq + 4 * h;
          const u32x2 zw = *(const u32x2*)(U + qtok * 4096 + ZCOL + hh * 64 + d);
          const float z0 = __uint_as_float(zw[0] << 16), z1 = __uint_as_float(zw[0] & 0xffff0000u), z2 = __uint_as_float(zw[1] << 16), z3 = __uint_as_float(zw[1] & 0xffff0000u);
          u32x2 ow = {pk2(O[db][4 * rq] * rl * z0, O[db][4 * rq + 1] * rl * z1), pk2(O[db][4 * rq + 2] * rl * z2, O[db][4 * rq + 3] * rl * z3)};
          *(u32x2*)(G + qtok * 1024 + 512 + hh * 64 + d) = ow;
        }
    }
  } else {
    float* X = (float*)lds + (size_t)qs * 4096;
    if (j == 1 && umax >= 0) {
#pragma unroll
      for (int db = 0; db < C::NDB; ++db)
#pragma unroll
        for (int r = 0; r < 16; ++r) X[(db * 16 + r) * 64 + l] = O[db][r] * rl;
    }
    __syncthreads();
    if (j == 0 && umax >= 0) {
      float ss = 0.f;
#pragma unroll
      for (int db = 0; db < C::NDB; ++db)
#pragma unroll
        for (int r = 0; r < 16; ++r) { const float d = O[db][r] * rl - lam * X[(db * 16 + r) * 64 + l]; O[db][r] = d; ss += d * d; }
      ss += __shfl_xor(ss, 32);
      const float rstd = rsqrtf(ss * (1.f / 128.f) + 1e-6f) * 0.8f;
#pragma unroll
      for (int db = 0; db < C::NDB; ++db)
#pragma unroll
        for (int rq = 0; rq < 4; ++rq) {
          const int d = db * 32 + 8 * rq + 4 * h;
          const f32x4 gv = *(const f32x4*)(p.subln_g + d);
          const u32x2 zw = *(const u32x2*)(U + qtok * 4096 + ZCOL + hh * 128 + d);
          const float z0 = __uint_as_float(zw[0] << 16), z1 = __uint_as_float(zw[0] & 0xffff0000u), z2 = __uint_as_float(zw[1] << 16), z3 = __uint_as_float(zw[1] & 0xffff0000u);
          u32x2 ow = {pk2(O[db][4 * rq] * rstd * gv[0] * z0, O[db][4 * rq + 1] * rstd * gv[1] * z1), pk2(O[db][4 * rq + 2] * rstd * gv[2] * z2, O[db][4 * rq + 3] * rstd * gv[3] * z3)};
          *(u32x2*)(G + qtok * 1024 + hh * 128 + d) = ow;
        }
    }
    __syncthreads();
  }
}


constexpr int Q_LEN = 140;
DI void phase_attn(const Params& p, char* lds, int tid, int which = 0) {
  unsigned* qh = (unsigned*)(p.ws + WS_CTRL) + which * 8 * 16;
  int* s_item = (int*)(lds + LDS_BYTES - 16);
  const int xcc = (int)(__builtin_amdgcn_s_getreg((3 << 11) | 20) & 7u);
  for (;;) {
    if (tid == 0) {
      int found = -1;
      for (int a = 0; a < 8 && found < 0; ++a) {
        const int y = (xcc + a) & 7;
        if (__hip_atomic_load(qh + y * 16, __ATOMIC_RELAXED, __HIP_MEMORY_SCOPE_AGENT) >= (unsigned)Q_LEN) continue;
        const unsigned v = atomicAdd(qh + y * 16, 1u);
        if (v < (unsigned)Q_LEN) found = y * 256 + (int)v;
      }
      *s_item = found;
    }
    __syncthreads();
    const int it = *s_item;
    __syncthreads();
    if (it < 0) break;
    const int x = it >> 8, i = it & 255;
    if (i < 64) attn_item<false>(p, lds, false, x & 3, 2 * (63 - i) + (x >> 2), tid);
    else if (i < 128) attn_item<true>(p, lds, false, x, 127 - i, tid);
    else if (i < 132) { const int e = x * 4 + (i - 128); attn_item<false>(p, lds, true, e & 3, e >> 2, tid); }
    else { const int e = x * 8 + (i - 132); attn_item<true>(p, lds, true, e & 7, e >> 3, tid); }
  }
}

template <int NBW>
DI void gemm2_tile(const Params& p, char* lds, int mt, int ncol0, int tid) {
  const int w = __builtin_amdgcn_readfirstlane(tid >> 6), l = tid & 63, r32 = l & 31, h = l >> 5, wa = w & 1, wb = w >> 1;
  const short* G = (const short*)(p.ws + WS_H);
  const short* Wt = (const short*)(p.ws + WS_WTOUT);
  const float* modp = (const float*)(p.ws + WS_MOD);
  f32x16 acc[2][NBW];
  gemm_main<NBW>(G + (size_t)mt * 128 * 1024, Wt + (size_t)ncol0 * 1024, lds, acc, tid);
  const int tok0 = mt * 128 + wa * 64;
  const bool prm = tok0 < TP;
  const float* gatep = modp + (prm ? 0 : 1 + ((tok0 - TP) >> 6)) * 3072 + 2048;
  const float* xb = prm ? p.x_prompt + (size_t)tok0 * 1024 : p.x_sample + (size_t)(tok0 - TP) * 1024;
  float* yb = prm ? p.out + O_Y + (size_t)tok0 * 1024 : p.out + O_YS + (size_t)(tok0 - TP) * 1024;
  char* scr = lds + w * 12288;
  constexpr int SP = 272, LPR = 8 * NBW, RPI = 64 / LPR, NIT = 32 / RPI;
  const int ncw = ncol0 + wb * 32 * NBW;
  const f32x4 gate4 = *(const f32x4*)(gatep + ncw + (l % LPR) * 4);
#pragma unroll
  for (int ab = 0; ab < 2; ++ab) {
#pragma unroll
    for (int bb = 0; bb < NBW; ++bb)
#pragma unroll
      for (int r = 0; r < 16; ++r) *(float*)(scr + (crow0(r) + 4 * h) * SP + (bb * 32 + r32) * 4) = acc[ab][bb][r];
#pragma unroll
    for (int i = 0; i < NIT; ++i) {
      const int row = RPI * i + l / LPR;
      const f32x4 o = *(const f32x4*)(scr + row * SP + (l % LPR) * 16);
      const size_t off = (size_t)(ab * 32 + row) * 1024 + ncw + (l % LPR) * 4;
      const f32x4 xv = *(const f32x4*)(xb + off);
      *(f32x4*)(yb + off) = xv + gate4 * o;
    }
  }
  __syncthreads();
}
DI void phase_gemm2(const Params& p, char* lds, int bid, int nb, int tid) {
  constexpr int NT = 132 * 4;
  const int full = (NT / nb) * nb;
  for (int tile = bid; tile < full; tile += nb) gemm2_tile<2>(p, lds, tile >> 2, (tile & 3) * 256, tid);
  for (int ht = bid; ht < (NT - full) * 2; ht += nb) { const int tile = full + (ht >> 1); gemm2_tile<1>(p, lds, tile >> 2, (tile & 3) * 256 + (ht & 1) * 128, tid); }
}

constexpr size_t XB_SUB = 8192, XB_GEN = 8192 + 4096, XB_TOP = 8192 + 8192, XB_TOPGEN = XB_TOP + 256, XB_XCC = 20480;
DI unsigned xb_ld(unsigned* p) { return __hip_atomic_load(p, __ATOMIC_RELAXED, __HIP_MEMORY_SCOPE_AGENT); }
DI unsigned xb_add(unsigned* p, unsigned v) { return __hip_atomic_fetch_add(p, v, __ATOMIC_RELAXED, __HIP_MEMORY_SCOPE_AGENT); }
DI void xcd_barrier(char* ctrl, const unsigned* st, unsigned k) {
  asm volatile("s_waitcnt vmcnt(0)" ::: "memory");
  __syncthreads();
  if (threadIdx.x == 0) {
    const unsigned x = st[0], nloc = st[1], nx = st[2];
    unsigned* xsub = (unsigned*)(ctrl + XB_SUB + 256 * x); unsigned* xgen = (unsigned*)(ctrl + XB_GEN + 256 * x);
    unsigned* top = (unsigned*)(ctrl + XB_TOP); unsigned* topgen = (unsigned*)(ctrl + XB_TOPGEN);
    unsigned spins = 0;
    const unsigned old = xb_add(xsub, 1u);
    if (old + 1u == k * nloc) {
      __builtin_amdgcn_fence(__ATOMIC_RELEASE, "agent");
      asm volatile("s_waitcnt vmcnt(0)" ::: "memory");
      const unsigned og = xb_add(top, 1u);
      if (og + 1u == k * nx) xb_add(topgen, 1u);
      else while (xb_ld(topgen) < k) { __builtin_amdgcn_s_sleep(1); if (++spins > (1u << 24)) break; }
      __builtin_amdgcn_fence(__ATOMIC_ACQUIRE, "agent");
      xb_add(xgen, 1u);
      asm volatile("s_waitcnt vmcnt(0)" ::: "memory");
    } else {
      while (xb_ld(xgen) < k) { __builtin_amdgcn_s_sleep(1); if (++spins > (1u << 24)) break; }
      __builtin_amdgcn_fence(__ATOMIC_ACQUIRE, "agent");
      asm volatile("s_waitcnt vmcnt(0)" ::: "memory");
    }
  }
  __syncthreads();
}

extern __shared__ __attribute__((aligned(16))) char smem[];

__global__ void __launch_bounds__(NTHR, 1) mega_kernel(Params p) {
  cg::grid_group grid = cg::this_grid(); (void)grid;
  const int tid = threadIdx.x, bid = blockIdx.x, nb = gridDim.x;
  unsigned* xst = (unsigned*)(smem + LDS_BYTES - 32);
  const unsigned my_xcc = __builtin_amdgcn_s_getreg((3 << 11) | 20) & 7u;
  unsigned* census = (unsigned*)(p.ws + WS_CTRL + XB_XCC);
  if (tid == 0) xb_add(census + 64 * my_xcc, 1u);
  { constexpr int JS = J_MOD + J_MISC;
    if (nb > 2 * JS) { if (bid < JS) { phase_prep(p, smem, 0, JS, bid, nb, tid); phase_prep(p, smem, JS, 3 * JS, bid, JS, tid); }
      else phase_prep(p, smem, 3 * JS, J_HEAD, bid - JS, nb - JS, tid); }
    else phase_prep(p, smem, 0, J_HEAD, bid, nb, tid); }
  if (tid == 0) {
    unsigned tot = 0, nx = 0, mine = 0, spins = 0;
    for (;;) { tot = 0; nx = 0;
      for (int x = 0; x < 8; ++x) { const unsigned c = xb_ld(census + 64 * x); tot += c; nx += c ? 1u : 0u; if ((unsigned)x == my_xcc) mine = c; }
      if (tot >= (unsigned)nb || ++spins > (1u << 22)) break;
      __builtin_amdgcn_s_sleep(2); }
    xst[0] = my_xcc; xst[1] = mine; xst[2] = nx;
  }
  __syncthreads();
  xcd_barrier(p.ws + WS_CTRL, xst, 1u);
  phase_hpass(p, smem, bid, nb, tid);
#if PROBE == 5
  phase_hpass(p, smem, bid, nb, tid);
#endif
  xcd_barrier(p.ws + WS_CTRL, xst, 2u);
  phase_gemm1(p, smem, bid, nb, tid);
  { const int extra = (66 * 32) % nb;
    if (bid >= extra) {
      for (int job = bid - extra; job < 72; job += nb - extra) { scan_job(p, smem, job, tid); __syncthreads(); }
      phase_prep(p, smem, J_HEAD, J_TOTAL, bid - extra, nb - extra, tid); } }
  xcd_barrier(p.ws + WS_CTRL, xst, 3u);
  phase_attn(p, smem, tid);
#if PROBE == 1
  phase_attn(p, smem, tid, 1);
#endif
  xcd_barrier(p.ws + WS_CTRL, xst, 4u);
  phase_gemm2(p, smem, bid, nb, tid);
#if PROBE == 3
  phase_gemm2(p, smem, bid, nb, tid);
#endif
}

#if MK_LAUNCHES != 1
__global__ void __launch_bounds__(NTHR, 1) k_prep(Params p) { phase_prep(p, smem, 0, J_TOTAL, blockIdx.x, gridDim.x, threadIdx.x); }
__global__ void __launch_bounds__(NTHR, 1) k_hpass(Params p) { phase_hpass(p, smem, blockIdx.x, gridDim.x, threadIdx.x); }
__global__ void __launch_bounds__(NTHR, 1) k_gemm1(Params p) {
  for (int job = blockIdx.x; job < 72; job += gridDim.x) { scan_job(p, smem, job, threadIdx.x); __syncthreads(); }
  phase_gemm1(p, smem, blockIdx.x, gridDim.x, threadIdx.x);
}
__global__ void __launch_bounds__(NTHR, 1) k_attn(Params p) { phase_attn(p, smem, threadIdx.x); }
__global__ void __launch_bounds__(NTHR, 1) k_gemm2(Params p) { phase_gemm2(p, smem, blockIdx.x, gridDim.x, threadIdx.x); }
#endif

extern "C" void kernel_launch(void* const* d_in, const int* in_sizes, int n_in, void* d_out, int out_size, void* d_ws, size_t ws_size, hipStream_t stream) {
  Params p{};
  const float** pp = (const float**)&p;
  for (int i = 0; i < 24; ++i) pp[i] = (const float*)d_in[i];
  p.out = (float*)d_out; p.ws = (char*)d_ws;
  if (ws_size < WS_END) { fprintf(stderr, "workspace too small: %zu < %zu\n", ws_size, (size_t)WS_END); return; }
#if MK_LAUNCHES == 1
  static int grid_blocks = 0;
  if (!grid_blocks) {
    int dev = 0, cus = 0, per_cu = 0;
    hipGetDevice(&dev);
    hipDeviceGetAttribute(&cus, hipDeviceAttributeMultiprocessorCount, dev);
    hipFuncSetAttribute((const void*)mega_kernel, hipFuncAttributeMaxDynamicSharedMemorySize, LDS_BYTES);
    hipOccupancyMaxActiveBlocksPerMultiprocessor(&per_cu, mega_kernel, NTHR, LDS_BYTES);
    if (per_cu < 1) { fprintf(stderr, "occupancy query returned %d\n", per_cu); per_cu = 1; }
    if (per_cu > 1) per_cu = 1;
    grid_blocks = cus * per_cu;
  }
  (void)hipMemsetAsync((char*)d_ws + WS_CTRL, 0, 32768, stream);
  void* args[] = {&p};
  hipError_t e = hipLaunchCooperativeKernel((void*)mega_kernel, dim3(grid_blocks), dim3(NTHR), args, LDS_BYTES, stream);
  if (e != hipSuccess) fprintf(stderr, "cooperative launch failed: %s (grid %d)\n", hipGetErrorString(e), grid_blocks);
#else
  static int init = 0;
  if (!init) {
    hipFuncSetAttribute((const void*)k_prep, hipFuncAttributeMaxDynamicSharedMemorySize, LDS_BYTES);
    hipFuncSetAttribute((const void*)k_hpass, hipFuncAttributeMaxDynamicSharedMemorySize, LDS_BYTES);
    hipFuncSetAttribute((const void*)k_gemm1, hipFuncAttributeMaxDynamicSharedMemorySize, LDS_BYTES);
    hipFuncSetAttribute((const void*)k_attn, hipFuncAttributeMaxDynamicSharedMemorySize, LDS_BYTES);
    hipFuncSetAttribute((const void*)k_gemm2, hipFuncAttributeMaxDynamicSharedMemorySize, LDS_BYTES);
    init = 1;
  }
  k_prep<<<256, NTHR, LDS_BYTES, stream>>>(p);
  k_hpass<<<256, NTHR, LDS_BYTES, stream>>>(p);
  k_gemm1<<<256, NTHR, LDS_BYTES, stream>>>(p);
  k_attn<<<256, NTHR, LDS_BYTES, stream>>>(p);
  k_gemm2<<<256, NTHR, LDS_BYTES, stream>>>(p);
#endif
}
```
